# Optimizing an MI355X kernel written in HIP

```python
import jax, jax.numpy as jnp
from jax import lax
import numpy as np

D_MODEL = 1024
BATCH = 4
SEQ = 4096
DEPTH = 1

FOX_HEADS = 8
FOX_HEAD_DIM = 64
FOX_WIDTH = FOX_HEADS * FOX_HEAD_DIM
Q_BLOCK = 128
RET_HEADS = 8
RET_QK_DIM = 64
RET_V_DIM = 128
RET_QK_WIDTH = RET_HEADS * RET_QK_DIM
RET_V_WIDTH = RET_HEADS * RET_V_DIM
RET_CHUNK = 128
ROPE_BASE = 10000.0
SPLIT_SIZES = (FOX_WIDTH, FOX_WIDTH, FOX_WIDTH, FOX_HEADS,
               RET_QK_WIDTH, RET_QK_WIDTH, RET_V_WIDTH, RET_V_WIDTH,
               D_MODEL, D_MODEL)
IN_WIDTH = 3 * FOX_WIDTH + FOX_HEADS + 2 * RET_QK_WIDTH + 2 * RET_V_WIDTH + 2 * D_MODEL
N_EXPERTS = 256
TOP_K = 8
N_GROUPS = 8
TOPK_GROUPS = 4
EXPERT_DIM = 256
SHARED_DIM = 256
ROUTED_SCALE = 2.5
EXPERT_BLOCK = 128
NORM_EPS = 1e-6

kernel_name = "fox_retnet_griffin_merge_dsv3_moe_adaln"


def rms_norm(x, g):
    xf = x.astype(jnp.float32)
    y = xf * lax.rsqrt(jnp.mean(xf * xf, axis=-1, keepdims=True) + NORM_EPS)
    return (y * g.astype(jnp.float32)).astype(x.dtype)


def forgetting_attention(q, k, v, log_f):
    b, s, h, dh = q.shape
    q = q.transpose(0, 2, 1, 3)
    k = k.transpose(0, 2, 1, 3)
    v = v.transpose(0, 2, 1, 3)
    cum_f = jnp.cumsum(log_f, axis=1).transpose(0, 2, 1)
    scale = dh ** -0.5
    outs = []
    for i in range(s // Q_BLOCK):
        q0, q1 = i * Q_BLOCK, (i + 1) * Q_BLOCK
        qb = q[:, :, q0:q1]
        kp, vp = k[:, :, :q1], v[:, :, :q1]
        logits = jnp.einsum('bhqd,bhkd->bhqk', qb, kp).astype(jnp.float32) * scale
        logits = logits + cum_f[:, :, q0:q1, None] - cum_f[:, :, None, :q1]
        causal = jnp.arange(q1)[None, :] <= (q0 + jnp.arange(Q_BLOCK))[:, None]
        logits = jnp.where(causal, logits, -jnp.inf)
        p = jax.nn.softmax(logits, axis=-1)
        outs.append(jnp.einsum('bhqk,bhkd->bhqd', p.astype(vp.dtype), vp))
    o = jnp.concatenate(outs, axis=2)
    return o.transpose(0, 2, 1, 3).reshape(b, s, h * dh)


def rotary(x, pos):
    half = x.shape[-1] // 2
    inv_freq = ROPE_BASE ** (-jnp.arange(half, dtype=jnp.float32) / half)
    ang = pos.astype(jnp.float32)[:, None] * inv_freq[None, :]
    cos, sin = jnp.cos(ang)[None, :, None, :], jnp.sin(ang)[None, :, None, :]
    x1, x2 = x[..., :half], x[..., half:]
    return jnp.concatenate([x1 * cos - x2 * sin, x1 * sin + x2 * cos], axis=-1)


def chunkwise_retention(q, k, v):
    b, s, h, dk = q.shape
    dv = v.shape[-1]
    n = s // RET_CHUNK
    c = RET_CHUNK
    log_gamma = jnp.log1p(-jnp.exp2(-5.0 - jnp.arange(h, dtype=jnp.float32)))
    to_chunks = lambda t: t.reshape(b, n, c, h, t.shape[-1]).transpose(0, 3, 1, 2, 4)
    qc, kc, vc = to_chunks(q), to_chunks(k * dk ** -0.5), to_chunks(v)
    idx = jnp.arange(c, dtype=jnp.float32)
    diff = idx[:, None] - idx[None, :]
    intra_decay = jnp.where(diff >= 0,
                            jnp.exp(jnp.maximum(diff, 0.0)[None] * log_gamma[:, None, None]),
                            0.0)
    scores = jnp.einsum('bhnid,bhnjd->bhnij', qc, kc) * intra_decay[None, :, None]
    intra = jnp.einsum('bhnij,bhnje->bhnie', scores, vc)
    zeta = jnp.exp((c - 1.0 - idx)[None, :] * log_gamma[:, None])
    xi = jnp.exp((idx + 1.0)[None, :] * log_gamma[:, None])
    chunk_decay = jnp.exp(c * log_gamma)[:, None, None]
    kv = jnp.einsum('bhncd,bhnce->bhnde', kc * zeta[None, :, None, :, None], vc)
    kv = jnp.moveaxis(kv, 2, 0)

    def step(state, kv_n):
        return chunk_decay * state + kv_n, state

    _, prev = lax.scan(step, jnp.zeros((b, h, dk, dv), jnp.float32), kv)
    prev = jnp.moveaxis(prev, 0, 2)
    cross = jnp.einsum('bhncd,bhnde->bhnce', qc, prev) * xi[None, :, None, :, None]
    o = intra + cross
    return o.transpose(0, 2, 3, 1, 4).reshape(b, s, h, dv)


def mixing_sublayer(h, w_in, b_forget, ret_gn_g, w_branch_a, w_branch_b, w_out):
    b, s, _ = h.shape
    proj = jnp.einsum('bsd,de->bse', h, w_in)
    fq, fk, fv, ff, rq, rk, rv, rg, ga, gb = jnp.split(
        proj, list(np.cumsum(SPLIT_SIZES)[:-1]), axis=-1)
    heads_a = lambda t: t.reshape(b, s, FOX_HEADS, FOX_HEAD_DIM)
    log_f = jax.nn.log_sigmoid(ff.astype(jnp.float32) + b_forget.astype(jnp.float32))
    y_a = forgetting_attention(heads_a(fq), heads_a(fk), heads_a(fv), log_f)
    y_a = jnp.einsum('bse,ed->bsd', y_a, w_branch_a)
    pos = jnp.arange(s)
    rq = rotary(rq.astype(jnp.float32).reshape(b, s, RET_HEADS, RET_QK_DIM), pos)
    rk = rotary(rk.astype(jnp.float32).reshape(b, s, RET_HEADS, RET_QK_DIM), pos)
    rv = rv.astype(jnp.float32).reshape(b, s, RET_HEADS, RET_V_DIM)
    o = chunkwise_retention(rq, rk, rv)
    mu = jnp.mean(o, axis=-1, keepdims=True)
    var = jnp.mean(jnp.square(o - mu), axis=-1, keepdims=True)
    o = ((o - mu) * lax.rsqrt(var + NORM_EPS)).reshape(b, s, RET_V_WIDTH)
    o = (o * ret_gn_g.astype(jnp.float32)).astype(h.dtype) * jax.nn.silu(rg)
    y_b = jnp.einsum('bse,ed->bsd', o, w_branch_b)
    merged = jax.nn.sigmoid(ga) * y_a + jax.nn.sigmoid(gb) * y_b
    return jnp.einsum('bsd,de->bse', merged, w_out)


def swiglu(x, wg, wu, wd):
    return (jax.nn.silu(x @ wg) * (x @ wu)) @ wd


def moe_sublayer(h, w_router, router_bias, w_exp_gate, w_exp_up, w_exp_down,
                 w_sh_gate, w_sh_up, w_sh_down):
    b, s, d = h.shape
    hf = h.reshape(b * s, d)
    t = hf.shape[0]
    scores = jax.nn.sigmoid((hf @ w_router).astype(jnp.float32))
    sel = scores + router_bias.astype(jnp.float32)
    grp = sel.reshape(t, N_GROUPS, N_EXPERTS // N_GROUPS)
    group_scores = lax.top_k(grp, 2)[0].sum(-1)
    top_groups = lax.top_k(group_scores, TOPK_GROUPS)[1]
    group_mask = jax.nn.one_hot(top_groups, N_GROUPS, dtype=jnp.float32).sum(-2) > 0
    expert_mask = jnp.repeat(group_mask, N_EXPERTS // N_GROUPS, axis=-1)
    _, top_e = lax.top_k(jnp.where(expert_mask, sel, -jnp.inf), TOP_K)
    top_w = jnp.take_along_axis(scores, top_e, axis=-1)
    top_w = top_w / jnp.sum(top_w, axis=-1, keepdims=True) * ROUTED_SCALE
    a = t * TOP_K
    e_flat = top_e.reshape(a)
    w_flat = top_w.reshape(a).astype(hf.dtype)
    tok_flat = jnp.repeat(jnp.arange(t, dtype=jnp.int32), TOP_K)
    order = jnp.argsort(e_flat)
    e_sorted = e_flat[order]
    counts = jnp.zeros((N_EXPERTS,), jnp.int32).at[e_flat].add(1)
    padded = (counts + EXPERT_BLOCK - 1) // EXPERT_BLOCK * EXPERT_BLOCK
    pad_end = jnp.cumsum(padded)
    pad_start = pad_end - padded
    start = jnp.cumsum(counts) - counts
    dest = pad_start[e_sorted] + jnp.arange(a, dtype=jnp.int32) - start[e_sorted]
    n_blocks = (a + N_EXPERTS * (EXPERT_BLOCK - 1) + EXPERT_BLOCK - 1) // EXPERT_BLOCK
    p = n_blocks * EXPERT_BLOCK
    buf_tok = jnp.full((p,), t, jnp.int32).at[dest].set(tok_flat[order])
    buf_w = jnp.zeros((p,), hf.dtype).at[dest].set(w_flat[order])
    block_expert = jnp.minimum(
        jnp.searchsorted(pad_end, jnp.arange(n_blocks, dtype=jnp.int32) * EXPERT_BLOCK,
                         side='right'), N_EXPERTS - 1)
    hp = jnp.concatenate([hf, jnp.zeros((1, d), hf.dtype)], axis=0)

    def block_fn(args):
        tok, wb, e = args
        xb = hp[tok]
        return swiglu(xb, w_exp_gate[e], w_exp_up[e], w_exp_down[e]) * wb[:, None]

    out = lax.map(block_fn, (buf_tok.reshape(n_blocks, EXPERT_BLOCK),
                             buf_w.reshape(n_blocks, EXPERT_BLOCK), block_expert))
    routed = jax.ops.segment_sum(out.reshape(p, d), buf_tok, num_segments=t + 1)[:t]
    shared = swiglu(hf, w_sh_gate, w_sh_up, w_sh_down)
    return (routed + shared).reshape(b, s, d)


def setup_inputs(seed: int = 0) -> dict:
    key = jax.random.key(seed)
    ks = jax.random.split(key, 24)
    nrm = lambda k, shape, sc: jax.random.normal(k, shape, jnp.float32) * sc
    return {
        "x": nrm(ks[0], (BATCH, SEQ, D_MODEL), 1.0),
        "c": nrm(ks[1], (BATCH, D_MODEL), 1.0),
        "w_ada": nrm(ks[2], (DEPTH, D_MODEL, 6 * D_MODEL), 0.1 * D_MODEL ** -0.5),
        "b_ada": nrm(ks[3], (DEPTH, 6 * D_MODEL), 0.1),
        "norm1_g": 1.0 + nrm(ks[4], (DEPTH, D_MODEL), 0.02),
        "w_in": nrm(ks[5], (DEPTH, D_MODEL, IN_WIDTH), D_MODEL ** -0.5),
        "b_forget": 3.0 + nrm(ks[6], (DEPTH, FOX_HEADS), 0.5),
        "ret_gn_g": 1.0 + nrm(ks[7], (DEPTH, RET_V_WIDTH), 0.02),
        "w_branch_a": nrm(ks[8], (DEPTH, FOX_WIDTH, D_MODEL), FOX_WIDTH ** -0.5),
        "w_branch_b": nrm(ks[9], (DEPTH, RET_V_WIDTH, D_MODEL), RET_V_WIDTH ** -0.5),
        "w_out": nrm(ks[10], (DEPTH, D_MODEL, D_MODEL), D_MODEL ** -0.5),
        "norm2_g": 1.0 + nrm(ks[11], (DEPTH, D_MODEL), 0.02),
        "w_router": nrm(ks[12], (DEPTH, D_MODEL, N_EXPERTS), D_MODEL ** -0.5),
        "router_bias": nrm(ks[13], (DEPTH, N_EXPERTS), 0.01),
        "w_exp_gate": nrm(ks[14], (DEPTH, N_EXPERTS, D_MODEL, EXPERT_DIM), D_MODEL ** -0.5),
        "w_exp_up": nrm(ks[15], (DEPTH, N_EXPERTS, D_MODEL, EXPERT_DIM), D_MODEL ** -0.5),
        "w_exp_down": nrm(ks[16], (DEPTH, N_EXPERTS, EXPERT_DIM, D_MODEL), EXPERT_DIM ** -0.5),
        "w_sh_gate": nrm(ks[17], (DEPTH, D_MODEL, SHARED_DIM), D_MODEL ** -0.5),
        "w_sh_up": nrm(ks[18], (DEPTH, D_MODEL, SHARED_DIM), D_MODEL ** -0.5),
        "w_sh_down": nrm(ks[19], (DEPTH, SHARED_DIM, D_MODEL), SHARED_DIM ** -0.5),
        "final_g": 1.0 + nrm(ks[20], (D_MODEL,), 0.02),
    }


def reference(x, c, w_ada, b_ada, norm1_g, w_in, b_forget, ret_gn_g, w_branch_a,
              w_branch_b, w_out, norm2_g, w_router, router_bias, w_exp_gate, w_exp_up,
              w_exp_down, w_sh_gate, w_sh_up, w_sh_down, final_g):
    for l in range(DEPTH):
        mod = jax.nn.silu(c) @ w_ada[l] + b_ada[l]
        shift1, scale1, gate1, shift2, scale2, gate2 = jnp.split(mod[:, None, :], 6, axis=-1)
        h = rms_norm(x, norm1_g[l]) * (1.0 + scale1) + shift1
        x = x + gate1 * mixing_sublayer(h, w_in[l], b_forget[l], ret_gn_g[l],
                                        w_branch_a[l], w_branch_b[l], w_out[l])
        h = rms_norm(x, norm2_g[l]) * (1.0 + scale2) + shift2
        x = x + gate2 * moe_sublayer(h, w_router[l], router_bias[l], w_exp_gate[l],
                                     w_exp_up[l], w_exp_down[l], w_sh_gate[l],
                                     w_sh_up[l], w_sh_down[l])
    return rms_norm(x, final_g)
```

```cpp
#include <hip/hip_runtime.h>
#include <stdint.h>
#include <cstdio>

typedef unsigned short bf16_t;
typedef short bf16x8 __attribute__((ext_vector_type(8)));
typedef float f32x4 __attribute__((ext_vector_type(4)));

constexpr int T_ = 16384, D_ = 1024, S_ = 4096, NBATCH = 4;
constexpr int NIN = 6912;
constexpr int NE = 256, CAP = 16384, TOPK = 8;
constexpr float EPS = 1e-6f;
constexpr float LOG2E = 1.4426950408889634f;
constexpr float C2 = 0.125f * LOG2E;

constexpr size_t MiB = 1u << 20;
constexpr size_t WS_CTL = 0;
constexpr size_t WS_MOD = 1 * MiB;
constexpr size_t WS_COS = 1 * MiB + 256 * 1024;
constexpr size_t WS_SIN = WS_COS + 512 * 1024;
constexpr size_t WS_F2 = 2 * MiB + 512 * 1024;
constexpr size_t WS_LF = 3 * MiB;
constexpr size_t WS_BLK = 3 * MiB + 512 * 1024;
constexpr size_t WS_WIN = 8 * MiB;
constexpr size_t WS_WAB = 22 * MiB;
constexpr size_t WS_WO = 25 * MiB;
constexpr size_t WS_WRS = 27 * MiB;
constexpr size_t WS_WSD = 28 * MiB + 512 * 1024;
constexpr size_t WS_WEG = 32 * MiB;
constexpr size_t WS_WED = 288 * MiB;
constexpr size_t WS_XN = 416 * MiB;
constexpr size_t WS_QF = 448 * MiB, WS_KF = 464 * MiB, WS_VF = 480 * MiB, WS_RQ = 496 * MiB, WS_RK = 512 * MiB;
constexpr size_t WS_RV = 528 * MiB, WS_SG = 560 * MiB, WS_GA = 592 * MiB, WS_GB = 624 * MiB;
constexpr size_t WS_AO = 656 * MiB;
constexpr size_t WS_MRG = 704 * MiB;
constexpr size_t WS_X1 = 736 * MiB;
constexpr size_t WS_KVN = 800 * MiB;
constexpr size_t WS_SCORES = 832 * MiB;
constexpr size_t WS_HS = 848 * MiB;
constexpr size_t WS_LTOK = 860 * MiB;
constexpr size_t WS_LW = 876 * MiB;
constexpr size_t WS_HE = 892 * MiB;
constexpr size_t WS_YS = 448 * MiB;
constexpr size_t WS_END = 972 * MiB;

__device__ __forceinline__ float bf2f(bf16_t v) { return __uint_as_float(((unsigned)v) << 16); }
__device__ __forceinline__ bf16_t f2bf(float f) { unsigned u = __float_as_uint(f); return (bf16_t)((u + 0x7fffu + ((u >> 16) & 1u)) >> 16); }
__device__ __forceinline__ float sigmoidf_(float x) { return 1.0f / (1.0f + __expf(-x)); }
__device__ __forceinline__ float siluf_(float x) { return x / (1.0f + __expf(-x)); }
__device__ __forceinline__ float logsigmoidf_(float x) { return x >= 0.f ? -log1pf(expf(-x)) : x - log1pf(expf(x)); }
__device__ __forceinline__ float wave_sum(float v) {
#pragma unroll
    for (int o = 1; o < 64; o <<= 1) v += __shfl_xor(v, o);
    return v;
}

__global__ void k_transpose(const float* __restrict__ src, int K, int srcld, int c0, int ncols, bf16_t* __restrict__ dst, int dstld, int dcol0, int row0,
                            int g, int which, long src_bstride, long dst_bstride) {
    __shared__ float tile[32][33];
    src += (long)blockIdx.z * src_bstride; dst += (long)blockIdx.z * dst_bstride;
    const int j0 = blockIdx.x * 32, k0 = blockIdx.y * 32, tx = threadIdx.x, ty = threadIdx.y;
#pragma unroll
    for (int i = 0; i < 4; ++i) { const int k = k0 + ty + 8 * i, j = j0 + tx; tile[ty + 8 * i][tx] = (j < ncols) ? src[(long)k * srcld + c0 + j] : 0.f; }
    __syncthreads();
#pragma unroll
    for (int i = 0; i < 4; ++i) {
        const int j = j0 + ty + 8 * i, k = k0 + tx;
        if (j < ncols) { const int row = g ? (2 * g * (j / g) + which * g + (j % g)) : j; dst[(long)(row0 + row) * dstld + dcol0 + k] = f2bf(tile[tx][ty + 8 * i]); }
    }
}

__global__ void k_mod(const float* __restrict__ c, const float* __restrict__ w_ada, const float* __restrict__ b_ada, float* __restrict__ mod) {
    const int idx = blockIdx.x * blockDim.x + threadIdx.x; if (idx >= NBATCH * 6144) return;
    const int b = idx / 6144, j = idx % 6144; float s = 0.f;
    for (int d = 0; d < D_; ++d) { const float cv = c[b * D_ + d]; s += (cv / (1.0f + expf(-cv))) * w_ada[(long)d * 6144 + j]; }
    mod[idx] = s + b_ada[j];
}

__device__ __forceinline__ void sincos_cw(float x, float& s, float& c) {
    int j = (int)(x * 1.27323954473516f); float y = (float)j; if (j & 1) { ++j; y += 1.f; }
    j &= 7; float ss = 1.f, cs = 1.f; if (j > 3) { ss = -1.f; cs = -1.f; j -= 4; } if (j > 1) cs = -cs;
    x = ((x - y * 0.78515625f) - y * 2.4187564849853515625e-4f) - y * 3.77489497744594108e-8f;
    const float z = x * x;
    const float ps = ((-1.9515295891e-4f * z + 8.3321608736e-3f) * z - 1.6666654611e-1f) * z * x + x;
    const float pc = ((2.443315711809948e-5f * z - 1.388731625493765e-3f) * z + 4.166664568298827e-2f) * z * z - 0.5f * z + 1.0f;
    if (j == 2) { s = ss * pc; c = cs * ps; } else { s = ss * ps; c = cs * pc; }
}
__global__ void k_rope(float* __restrict__ ct, float* __restrict__ st) {
    const int idx = blockIdx.x * blockDim.x + threadIdx.x; if (idx >= S_ * 32) return;
    const int pos = idx >> 5, i = idx & 31;
    const float inv = powf(10000.0f, -(float)i / 32.0f); const float ang = (float)pos * inv;
    float s, c; sincos_cw(ang, s, c); ct[idx] = c; st[idx] = s;
}

__global__ void k_norm_mod(const float* __restrict__ x, const float* __restrict__ g, const float* __restrict__ mod, int shift_off, int scale_off, bf16_t* __restrict__ out) {
    const int row = blockIdx.x * 4 + (threadIdx.x >> 6), lane = threadIdx.x & 63; const int b = row / S_;
    const f32x4* xr = (const f32x4*)(x + (long)row * D_) + lane; f32x4 v[4]; float s = 0.f;
#pragma unroll
    for (int j = 0; j < 4; ++j) { v[j] = xr[64 * j]; s += v[j].x * v[j].x + v[j].y * v[j].y + v[j].z * v[j].z + v[j].w * v[j].w; }
    const float r = rsqrtf(wave_sum(s) * (1.f / D_) + EPS);
    const float* mb = mod + b * 6144;
#pragma unroll
    for (int j = 0; j < 4; ++j) {
        const int c0 = 4 * lane + 256 * j;
#pragma unroll
        for (int e = 0; e < 4; ++e) { const int cc = c0 + e; const float y = v[j][e] * r * g[cc]; out[(long)row * D_ + cc] = f2bf(y * (1.f + mb[scale_off + cc]) + mb[shift_off + cc]); }
    }
}

constexpr int LDS_STR = 40;
template <class ARow, class Epi>
__device__ __forceinline__ void gemm128_tile(const ARow& arow, const bf16_t* __restrict__ Bt, int ldb, int K, const Epi& epi, bf16_t* SA, bf16_t* SB) {
    const int tid = threadIdx.x, wid = tid >> 6, lane = tid & 63, wr = wid >> 1, wc = wid & 1, fr = lane & 15, fq = lane >> 4;
    f32x4 acc[4][4];
#pragma unroll
    for (int m = 0; m < 4; ++m)
#pragma unroll
        for (int n = 0; n < 4; ++n) acc[m][n] = (f32x4){0.f, 0.f, 0.f, 0.f};
    const int r0 = tid >> 2, cb = (tid & 3) * 8;
    const bf16_t* ap0 = arow(r0); const bf16_t* ap1 = arow(r0 + 64);
    const unsigned am0 = arow.ok(r0) ? 0xffffffffu : 0u, am1 = arow.ok(r0 + 64) ? 0xffffffffu : 0u;
    const bf16_t* bp0 = Bt + (long)r0 * ldb + cb; const bf16_t* bp1 = Bt + (long)(r0 + 64) * ldb + cb;
    for (int kt = 0; kt < K / 32; ++kt) {
        uint4 va0 = *(const uint4*)(ap0 + kt * 32 + cb), va1 = *(const uint4*)(ap1 + kt * 32 + cb);
        va0.x &= am0; va0.y &= am0; va0.z &= am0; va0.w &= am0; va1.x &= am1; va1.y &= am1; va1.z &= am1; va1.w &= am1;
        const uint4 vb0 = *(const uint4*)(bp0 + kt * 32), vb1 = *(const uint4*)(bp1 + kt * 32);
        __syncthreads();
        *(uint4*)(SA + r0 * LDS_STR + cb) = va0; *(uint4*)(SA + (r0 + 64) * LDS_STR + cb) = va1;
        *(uint4*)(SB + r0 * LDS_STR + cb) = vb0; *(uint4*)(SB + (r0 + 64) * LDS_STR + cb) = vb1;
        __syncthreads();
        bf16x8 a[4], b[4];
#pragma unroll
        for (int m = 0; m < 4; ++m) a[m] = *(const bf16x8*)(SA + (wr * 64 + m * 16 + fr) * LDS_STR + fq * 8);
#pragma unroll
        for (int n = 0; n < 4; ++n) b[n] = *(const bf16x8*)(SB + (wc * 64 + n * 16 + fr) * LDS_STR + fq * 8);
#pragma unroll
        for (int m = 0; m < 4; ++m)
#pragma unroll
            for (int n = 0; n < 4; ++n) acc[m][n] = __builtin_amdgcn_mfma_f32_16x16x32_bf16(a[m], b[n], acc[m][n], 0, 0, 0);
    }
    epi(acc, wr, wc, fr, fq);
}
struct ARowDense { const bf16_t* A; long lda; __device__ __forceinline__ const bf16_t* operator()(int r) const { return A + (long)r * lda; } __device__ __forceinline__ bool ok(int) const { return true; } };

struct InprojPtrs { const bf16_t* XN; const bf16_t* Win; bf16_t *QF, *KF, *VF, *RQ, *RK, *RV, *SG, *GA, *GB; float* LF; const float *COS, *SIN, *bforget; };
#define EPI_LOOP_MJ _Pragma("unroll") for (int m = 0; m < 4; ++m) _Pragma("unroll") for (int j = 0; j < 4; ++j)
struct EpiInproj {
    InprojPtrs p; int row0, gc0;
    template <int MODE> __device__ __forceinline__ void simple(const f32x4 (&acc)[4][4], bf16_t* O, int ld, int cbase, int wr, int wc, int fr, int fq) const {
        EPI_LOOP_MJ { const long row = row0 + wr * 64 + m * 16 + fq * 4 + j;
#pragma unroll
            for (int n = 0; n < 4; ++n) { float v = acc[m][n][j]; if (MODE == 1) v *= C2; else if (MODE == 2) v = siluf_(v); else if (MODE == 3) v = sigmoidf_(v);
                O[row * ld + cbase + wc * 64 + n * 16 + fr] = f2bf(v); } }
    }
    __device__ __forceinline__ void operator()(const f32x4 (&acc)[4][4], int wr, int wc, int fr, int fq) const {
        if (gc0 < 512) simple<1>(acc, p.QF, 512, gc0, wr, wc, fr, fq);
        else if (gc0 < 1024) simple<0>(acc, p.KF, 512, gc0 - 512, wr, wc, fr, fq);
        else if (gc0 < 1536) simple<0>(acc, p.VF, 512, gc0 - 1024, wr, wc, fr, fq);
        else if (gc0 < 2560) {
            const bool isq = gc0 < 2048; bf16_t* O = isq ? p.RQ : p.RK; const int cbase = (gc0 - (isq ? 1536 : 2048)) + wc * 64; const float sc = isq ? 1.f : 0.125f;
            EPI_LOOP_MJ { const long row = row0 + wr * 64 + m * 16 + fq * 4 + j; const int pos = (int)(row % S_);
#pragma unroll
                for (int n = 0; n < 2; ++n) {
                    const int i = n * 16 + fr; const float cs = p.COS[pos * 32 + i], sn = p.SIN[pos * 32 + i];
                    const float x1 = acc[m][n][j], x2 = acc[m][n + 2][j];
                    O[row * 512 + cbase + i] = f2bf((x1 * cs - x2 * sn) * sc); O[row * 512 + cbase + 32 + i] = f2bf((x1 * sn + x2 * cs) * sc);
                } }
        }
        else if (gc0 < 3584) simple<0>(acc, p.RV, 1024, gc0 - 2560, wr, wc, fr, fq);
        else if (gc0 < 4608) simple<2>(acc, p.SG, 1024, gc0 - 3584, wr, wc, fr, fq);
        else if (gc0 < 5632) simple<3>(acc, p.GA, 1024, gc0 - 4608, wr, wc, fr, fq);
        else if (gc0 < 6656) simple<3>(acc, p.GB, 1024, gc0 - 5632, wr, wc, fr, fq);
        else if (gc0 == 6656 && wc == 0 && fr < 8) {
            EPI_LOOP_MJ { const long row = row0 + wr * 64 + m * 16 + fq * 4 + j; p.LF[row * 8 + fr] = logsigmoidf_(acc[m][0][j] + p.bforget[fr]); }
        }
    }
};
__global__ __launch_bounds__(256) void k_gemm_inproj(InprojPtrs p) {
    __shared__ __attribute__((aligned(16))) bf16_t SA[128 * LDS_STR]; __shared__ __attribute__((aligned(16))) bf16_t SB[128 * LDS_STR];
    const int bm = blockIdx.x % 128, bn = blockIdx.x / 128;
    ARowDense ar{p.XN + (long)bm * 128 * D_, D_}; EpiInproj e{p, bm * 128, bn * 128};
    gemm128_tile(ar, p.Win + (long)bn * 128 * D_, D_, D_, e, SA, SB);
}

struct DensePtrs { const bf16_t* A; long lda; const bf16_t* Bt; int ldb; int K; int ntn; int mode; bf16_t* O; const bf16_t* G; float* F; const float* X; const float* mod; bf16_t* O2; };
struct EpiDense {
    DensePtrs p; int row0, gc0;
    __device__ __forceinline__ void operator()(const f32x4 (&acc)[4][4], int wr, int wc, int fr, int fq) const {
        if (p.mode == 3 && gc0 >= 256) {
            EPI_LOOP_MJ { const long row = row0 + wr * 64 + m * 16 + fq * 4 + j;
#pragma unroll
                for (int n = 0; n < 2; ++n) { const int jj = ((gc0 - 256) >> 1) + wc * 32 + n * 16 + fr; p.O2[row * 256 + jj] = f2bf(siluf_(acc[m][n][j]) * acc[m][n + 2][j]); } }
        } else if (p.mode == 3) {
            EPI_LOOP_MJ { const long row = row0 + wr * 64 + m * 16 + fq * 4 + j;
#pragma unroll
                for (int n = 0; n < 4; ++n) p.F[row * 256 + gc0 + wc * 64 + n * 16 + fr] = sigmoidf_(acc[m][n][j]); }
        } else if (p.mode == 0) {
            EPI_LOOP_MJ { const long row = row0 + wr * 64 + m * 16 + fq * 4 + j;
#pragma unroll
                for (int n = 0; n < 4; ++n) { const long o = row * 1024 + gc0 + wc * 64 + n * 16 + fr; p.O[o] = f2bf(acc[m][n][j] * bf2f(p.G[o])); } }
        } else if (p.mode == 1) {
            EPI_LOOP_MJ { const long row = row0 + wr * 64 + m * 16 + fq * 4 + j;
#pragma unroll
                for (int n = 0; n < 4; ++n) { const long o = row * 1024 + gc0 + wc * 64 + n * 16 + fr; p.O[o] = f2bf(bf2f(p.O[o]) + acc[m][n][j] * bf2f(p.G[o])); } }
        } else if (p.mode == 2) {
            EPI_LOOP_MJ { const long row = row0 + wr * 64 + m * 16 + fq * 4 + j; const int b = (int)(row / S_);
#pragma unroll
                for (int n = 0; n < 4; ++n) { const int gcol = gc0 + wc * 64 + n * 16 + fr; const long o = row * 1024 + gcol; p.F[o] = p.X[o] + p.mod[b * 6144 + 2048 + gcol] * acc[m][n][j]; } }
        } else {
            EPI_LOOP_MJ { const long row = row0 + wr * 64 + m * 16 + fq * 4 + j;
#pragma unroll
                for (int n = 0; n < 4; ++n) p.O[row * 1024 + gc0 + wc * 64 + n * 16 + fr] = f2bf(acc[m][n][j]); }
        }
    }
};
__global__ __launch_bounds__(256) void k_gemm_dense(DensePtrs p) {
    __shared__ __attribute__((aligned(16))) bf16_t SA[128 * LDS_STR]; __shared__ __attribute__((aligned(16))) bf16_t SB[128 * LDS_STR];
    const int bn = blockIdx.x % p.ntn, bm = blockIdx.x / p.ntn;
    ARowDense ar{p.A + (long)bm * 128 * p.lda, p.lda}; EpiDense e{p, bm * 128, bn * 128};
    gemm128_tile(ar, p.Bt + (long)bn * 128 * p.ldb, p.ldb, p.K, e, SA, SB);
}

__global__ void k_cumsum(const float* __restrict__ LF, float* __restrict__ F2) {
    const int bh = blockIdx.x, b = bh >> 3, h = bh & 7, lane = threadIdx.x;
    const float* src = LF + ((long)b * S_ + lane * 64) * 8 + h;
    float s = 0.f; for (int i = 0; i < 64; ++i) s += src[i * 8];
    float incl = s;
#pragma unroll
    for (int o = 1; o < 64; o <<= 1) { const float t = __shfl_up(incl, o); if (lane >= o) incl += t; }
    float run = incl - s;
    for (int i = 0; i < 64; ++i) { run += src[i * 8]; F2[(long)bh * S_ + lane * 64 + i] = run * LOG2E; }
}

__global__ __launch_bounds__(256) void k_fox_naive(const bf16_t* __restrict__ QF, const bf16_t* __restrict__ KF, const bf16_t* __restrict__ VF, const float* __restrict__ F2, bf16_t* __restrict__ AO) {
    const int gw = blockIdx.x * 4 + (threadIdx.x >> 6), lane = threadIdx.x & 63;
    const int t = gw >> 3, h = gw & 7, b = t / S_, tq = t % S_, bh = b * 8 + h;
    float q[64];
    { const bf16_t* qp = QF + (long)t * 512 + h * 64;
#pragma unroll
      for (int d = 0; d < 64; ++d) q[d] = bf2f(qp[d]); }
    const float fq2 = F2[(long)bh * S_ + tq];
    float o[64];
#pragma unroll
    for (int d = 0; d < 64; ++d) o[d] = 0.f;
    float m = -INFINITY, l = 0.f;
    for (int k = lane; k <= tq; k += 64) {
        const long kr = (long)(b * S_ + k) * 512 + h * 64;
        float s = 0.f;
#pragma unroll
        for (int c = 0; c < 8; ++c) { const uint4 u = *(const uint4*)(KF + kr + c * 8); const unsigned w[4] = {u.x, u.y, u.z, u.w};
#pragma unroll
            for (int e = 0; e < 4; ++e) { s += q[c * 8 + 2 * e] * __uint_as_float(w[e] << 16); s += q[c * 8 + 2 * e + 1] * __uint_as_float(w[e] & 0xffff0000u); } }
        s += fq2 - F2[(long)bh * S_ + k];
        if (s > m) { const float f = exp2f(m - s); l *= f;
#pragma unroll
            for (int d = 0; d < 64; ++d) o[d] *= f;
            m = s; }
        const float p = exp2f(s - m); l += p;
#pragma unroll
        for (int c = 0; c < 8; ++c) { const uint4 u = *(const uint4*)(VF + kr + c * 8); const unsigned w[4] = {u.x, u.y, u.z, u.w};
#pragma unroll
            for (int e = 0; e < 4; ++e) { o[c * 8 + 2 * e] += p * __uint_as_float(w[e] << 16); o[c * 8 + 2 * e + 1] += p * __uint_as_float(w[e] & 0xffff0000u); } }
    }
    float M = m;
#pragma unroll
    for (int off = 1; off < 64; off <<= 1) M = fmaxf(M, __shfl_xor(M, off));
    const float f = (m == -INFINITY) ? 0.f : exp2f(m - M);
    const float lt = wave_sum(l * f); float mine = 0.f;
#pragma unroll
    for (int d = 0; d < 64; ++d) { const float v = wave_sum(o[d] * f); if (lane == d) mine = v; }
    AO[(long)t * 1536 + h * 64 + lane] = f2bf(mine / lt);
}

__device__ __forceinline__ float ret_loggamma(int h) { return log1pf(-exp2f(-5.0f - (float)h)); }
__global__ __launch_bounds__(256) void k_ret_kv(const bf16_t* __restrict__ RK, const bf16_t* __restrict__ RV, float* __restrict__ KVN) {
    __shared__ bf16_t sk[128 * 64]; __shared__ bf16_t sv[128 * 128];
    const int bh = blockIdx.x >> 5, n = blockIdx.x & 31, b = bh >> 3, h = bh & 7, tid = threadIdx.x;
    const long t0 = (long)b * S_ + n * 128;
    for (int i = tid; i < 128 * 64; i += 256) sk[i] = RK[(t0 + (i >> 6)) * 512 + h * 64 + (i & 63)];
    for (int i = tid; i < 128 * 128; i += 256) sv[i] = RV[(t0 + (i >> 7)) * 1024 + h * 128 + (i & 127)];
    __syncthreads();
    const int d = tid >> 2, e0 = (tid & 3) * 32; const float lg = ret_loggamma(h);
    float acc[32];
#pragma unroll
    for (int e = 0; e < 32; ++e) acc[e] = 0.f;
    for (int j = 0; j < 128; ++j) { const float kz = bf2f(sk[j * 64 + d]) * expf((127.f - (float)j) * lg);
#pragma unroll
        for (int e = 0; e < 32; ++e) acc[e] += kz * bf2f(sv[j * 128 + e0 + e]); }
    float* dst = KVN + (((long)bh * 32 + n) * 64 + d) * 128 + e0;
#pragma unroll
    for (int e = 0; e < 32; ++e) dst[e] = acc[e];
}
__global__ void k_ret_scan(float* __restrict__ KVN) {
    const int idx = blockIdx.x * blockDim.x + threadIdx.x; const int bh = idx >> 13, r = idx & 8191, h = bh & 7;
    const float cd = expf(128.f * ret_loggamma(h)); float st = 0.f;
    for (int n = 0; n < 32; ++n) { float* p = KVN + ((long)bh * 32 + n) * 8192 + r; const float tmp = *p; *p = st; st = cd * st + tmp; }
}
__global__ __launch_bounds__(256) void k_ret_out(const bf16_t* __restrict__ RQ, const bf16_t* __restrict__ RK, const bf16_t* __restrict__ RV, const float* __restrict__ PREV,
                                                 const float* __restrict__ gn_g, const bf16_t* __restrict__ SG, bf16_t* __restrict__ AO) {
    __shared__ bf16_t sk[128 * 64]; __shared__ bf16_t sv[128 * 128];
    const int bh = blockIdx.x >> 5, n = blockIdx.x & 31, b = bh >> 3, h = bh & 7, tid = threadIdx.x, i = tid >> 1, e0 = (tid & 1) * 64;
    const long t0 = (long)b * S_ + n * 128;
    for (int x = tid; x < 128 * 64; x += 256) sk[x] = RK[(t0 + (x >> 6)) * 512 + h * 64 + (x & 63)];
    for (int x = tid; x < 128 * 128; x += 256) sv[x] = RV[(t0 + (x >> 7)) * 1024 + h * 128 + (x & 127)];
    __syncthreads();
    const float lg = ret_loggamma(h); const long t = t0 + i;
    float acc[64];
#pragma unroll
    for (int e = 0; e < 64; ++e) acc[e] = 0.f;
    const bf16_t* qp = RQ + t * 512 + h * 64;
    for (int j = 0; j <= i; ++j) {
        float s = 0.f;
#pragma unroll 16
        for (int d = 0; d < 64; ++d) s += bf2f(qp[d]) * bf2f(sk[j * 64 + d]);
        s *= expf((float)(i - j) * lg);
#pragma unroll
        for (int e = 0; e < 64; ++e) acc[e] += s * bf2f(sv[j * 128 + e0 + e]);
    }
    const float xi = expf((float)(i + 1) * lg); const float* pv = PREV + ((long)bh * 32 + n) * 8192 + e0;
    for (int d = 0; d < 64; ++d) { const float qd = bf2f(qp[d]) * xi;
#pragma unroll
        for (int e = 0; e < 64; ++e) acc[e] += qd * pv[d * 128 + e]; }
    float mu = 0.f;
#pragma unroll
    for (int e = 0; e < 64; ++e) mu += acc[e];
    mu += __shfl_xor(mu, 1); mu *= (1.f / 128.f); float var = 0.f;
#pragma unroll
    for (int e = 0; e < 64; ++e) { const float dd = acc[e] - mu; var += dd * dd; }
    var += __shfl_xor(var, 1);
    const float rs = rsqrtf(var * (1.f / 128.f) + EPS);
#pragma unroll
    for (int e = 0; e < 64; ++e) { const float y = (acc[e] - mu) * rs * gn_g[h * 128 + e0 + e]; AO[t * 1536 + 512 + h * 128 + e0 + e] = f2bf(y * bf2f(SG[t * 1024 + h * 128 + e0 + e])); }
}

__global__ __launch_bounds__(256) void k_route(const float* __restrict__ SC, const float* __restrict__ rbias, unsigned* __restrict__ CNT, int* __restrict__ LTOK, float* __restrict__ LW) {
    const int t = blockIdx.x * 4 + (threadIdx.x >> 6), lane = threadIdx.x & 63;
    const f32x4 sc = *((const f32x4*)(SC + (long)t * 256) + lane); const f32x4 rb = *((const f32x4*)rbias + lane);
    float sel[4];
#pragma unroll
    for (int i = 0; i < 4; ++i) sel[i] = sc[i] + rb[i];
    float a1 = fmaxf(sel[0], sel[1]), a2 = fminf(sel[0], sel[1]);
    { const float b1 = fmaxf(sel[2], sel[3]), b2 = fminf(sel[2], sel[3]); const float n1 = fmaxf(a1, b1), n2 = fmaxf(fminf(a1, b1), fmaxf(a2, b2)); a1 = n1; a2 = n2; }
#pragma unroll
    for (int o = 1; o < 8; o <<= 1) { const float b1 = __shfl_xor(a1, o), b2 = __shfl_xor(a2, o); const float n1 = fmaxf(a1, b1), n2 = fmaxf(fminf(a1, b1), fmaxf(a2, b2)); a1 = n1; a2 = n2; }
    const float gs = a1 + a2; const int g = lane >> 3; int rank = 0;
#pragma unroll
    for (int gg = 0; gg < 8; ++gg) { const float o = __shfl(gs, gg * 8); rank += (o > gs || (o == gs && gg < g)) ? 1 : 0; }
    const bool allowed = rank < 4;
    float cand[4];
#pragma unroll
    for (int i = 0; i < 4; ++i) cand[i] = allowed ? sel[i] : -INFINITY;
    int myE = 0; float mySc = 0.f;
    for (int r = 0; r < TOPK; ++r) {
        float bv = cand[0]; int bi = lane * 4; float bs = sc[0];
#pragma unroll
        for (int i = 1; i < 4; ++i) if (cand[i] > bv) { bv = cand[i]; bi = lane * 4 + i; bs = sc[i]; }
#pragma unroll
        for (int o = 1; o < 64; o <<= 1) { const float ov = __shfl_xor(bv, o); const int oi = __shfl_xor(bi, o); const float os = __shfl_xor(bs, o);
            if (ov > bv || (ov == bv && oi < bi)) { bv = ov; bi = oi; bs = os; } }
        if ((bi >> 2) == lane) {
#pragma unroll
            for (int i = 0; i < 4; ++i) if ((bi & 3) == i) cand[i] = -INFINITY;
        }
        if (lane == r) { myE = bi; mySc = bs; }
    }
    float tot = (lane < TOPK) ? mySc : 0.f;
#pragma unroll
    for (int o = 1; o < 8; o <<= 1) tot += __shfl_xor(tot, o);
    if (lane < TOPK) { const float w = mySc / tot * 2.5f; const unsigned slot = atomicAdd(&CNT[myE], 1u); LTOK[(long)myE * CAP + slot] = t * 8 + lane; LW[(long)myE * CAP + slot] = w; }
}
__global__ void k_blocktable(const unsigned* __restrict__ CNT, int* __restrict__ BLK) {
    __shared__ int start[257];
    if (threadIdx.x == 0) { int s = 0; for (int e = 0; e < NE; ++e) { start[e] = s; s += ((int)CNT[e] + 127) >> 7; } start[256] = s; BLK[2048 + 256] = s; }
    __syncthreads();
    const int e = threadIdx.x; BLK[2048 + e] = start[e] * 128;
    for (int b = start[e]; b < start[e + 1]; ++b) BLK[b] = e;
}

struct MoePtrs { const bf16_t* H2; const bf16_t* WEG; const bf16_t* WED; const unsigned* CNT; const int* BLK; const int* LTOK; const float* LW; bf16_t* HE; bf16_t* YS; };
struct ARowGather { const bf16_t* H2; const int* ltok; int valid; __device__ __forceinline__ const bf16_t* operator()(int r) const { return H2 + (long)((r < valid ? ltok[r] : 0) >> 3) * D_; } __device__ __forceinline__ bool ok(int r) const { return r < valid; } };
struct EpiMoeUp {
    bf16_t* HE; long hrow0; int ct;
    __device__ __forceinline__ void operator()(const f32x4 (&acc)[4][4], int wr, int wc, int fr, int fq) const {
#pragma unroll
        for (int m = 0; m < 4; ++m)
#pragma unroll
            for (int j = 0; j < 4; ++j) { const long row = hrow0 + wr * 64 + m * 16 + fq * 4 + j;
#pragma unroll
                for (int n = 0; n < 2; ++n) HE[row * 256 + ct * 64 + wc * 32 + n * 16 + fr] = f2bf(siluf_(acc[m][n][j]) * acc[m][n + 2][j]); }
    }
};
__global__ __launch_bounds__(256) void k_moe_up(MoePtrs p) {
    __shared__ __attribute__((aligned(16))) bf16_t SA[128 * LDS_STR]; __shared__ __attribute__((aligned(16))) bf16_t SB[128 * LDS_STR];
    const int blk = blockIdx.x >> 2, ct = blockIdx.x & 3; if (blk >= p.BLK[2048 + 256]) return;
    const int e = p.BLK[blk], pst = p.BLK[2048 + e], s0 = blk * 128 - pst; int valid = (int)p.CNT[e] - s0; valid = valid > 128 ? 128 : valid;
    ARowGather ar{p.H2, p.LTOK + (long)e * CAP + s0, valid}; EpiMoeUp ep{p.HE, (long)pst + s0, ct};
    gemm128_tile(ar, p.WEG + ((long)e * 512 + ct * 128) * D_, D_, D_, ep, SA, SB);
}
struct EpiMoeDown {
    bf16_t* YS; const int* ltok; const float* lw; int valid, gc0;
    __device__ __forceinline__ void operator()(const f32x4 (&acc)[4][4], int wr, int wc, int fr, int fq) const {
#pragma unroll
        for (int m = 0; m < 4; ++m)
#pragma unroll
            for (int j = 0; j < 4; ++j) { const int r = wr * 64 + m * 16 + fq * 4 + j; if (r < valid) { const long dst = (long)ltok[r] * D_; const float w = lw[r];
#pragma unroll
                for (int n = 0; n < 4; ++n) YS[dst + gc0 + wc * 64 + n * 16 + fr] = f2bf(acc[m][n][j] * w); } }
    }
};
__global__ __launch_bounds__(256) void k_moe_down(MoePtrs p) {
    __shared__ __attribute__((aligned(16))) bf16_t SA[128 * LDS_STR]; __shared__ __attribute__((aligned(16))) bf16_t SB[128 * LDS_STR];
    const int blk = blockIdx.x >> 3, ct = blockIdx.x & 7; if (blk >= p.BLK[2048 + 256]) return;
    const int e = p.BLK[blk], pst = p.BLK[2048 + e], s0 = blk * 128 - pst; int valid = (int)p.CNT[e] - s0; valid = valid > 128 ? 128 : valid;
    ARowDense ar{p.HE + (long)(pst + s0) * 256, 256}; EpiMoeDown ep{p.YS, p.LTOK + (long)e * CAP + s0, p.LW + (long)e * CAP + s0, valid, ct * 128};
    gemm128_tile(ar, p.WED + ((long)e * 1024 + ct * 128) * 256, 256, 256, ep, SA, SB);
}

__global__ void k_final(const float* __restrict__ X1, const bf16_t* __restrict__ YS, const bf16_t* __restrict__ SHO, const float* __restrict__ mod, const float* __restrict__ fg, float* __restrict__ out) {
    const int row = blockIdx.x * 4 + (threadIdx.x >> 6), lane = threadIdx.x & 63; const int b = row / S_;
    float v[16]; float s = 0.f;
#pragma unroll
    for (int j = 0; j < 4; ++j)
#pragma unroll
        for (int e = 0; e < 4; ++e) {
            const int cc = 4 * lane + 256 * j + e; float r = bf2f(SHO[(long)row * D_ + cc]);
#pragma unroll
            for (int k = 0; k < 8; ++k) r += bf2f(YS[((long)row * 8 + k) * D_ + cc]);
            const float y = X1[(long)row * D_ + cc] + mod[b * 6144 + 5120 + cc] * r; v[j * 4 + e] = y; s += y * y;
        }
    const float rr = rsqrtf(wave_sum(s) * (1.f / D_) + EPS);
#pragma unroll
    for (int j = 0; j < 4; ++j)
#pragma unroll
        for (int e = 0; e < 4; ++e) { const int cc = 4 * lane + 256 * j + e; out[(long)row * D_ + cc] = v[j * 4 + e] * rr * fg[cc]; }
}

extern "C" void kernel_launch(void* const* d_in, const int* in_sizes, int n_in, void* d_out, int out_size, void* d_ws, size_t ws_size, hipStream_t stream) {
    if (n_in != 21 || ws_size < WS_END) { fprintf(stderr, "kernel_launch: unexpected n_in %d / ws %zu\n", n_in, ws_size); return; }
    const float* x = (const float*)d_in[0]; const float* c = (const float*)d_in[1]; const float* w_ada = (const float*)d_in[2]; const float* b_ada = (const float*)d_in[3];
    const float* norm1_g = (const float*)d_in[4]; const float* w_in = (const float*)d_in[5]; const float* b_forget = (const float*)d_in[6]; const float* ret_gn_g = (const float*)d_in[7];
    const float* w_a = (const float*)d_in[8]; const float* w_b = (const float*)d_in[9]; const float* w_out = (const float*)d_in[10]; const float* norm2_g = (const float*)d_in[11];
    const float* w_router = (const float*)d_in[12]; const float* router_bias = (const float*)d_in[13]; const float* w_eg = (const float*)d_in[14]; const float* w_eu = (const float*)d_in[15];
    const float* w_ed = (const float*)d_in[16]; const float* w_sg = (const float*)d_in[17]; const float* w_su = (const float*)d_in[18]; const float* w_sd = (const float*)d_in[19]; const float* final_g = (const float*)d_in[20];
    char* ws = (char*)d_ws; float* out = (float*)d_out;
    unsigned* CNT = (unsigned*)(ws + WS_CTL); float* MOD = (float*)(ws + WS_MOD); float* COS = (float*)(ws + WS_COS); float* SIN = (float*)(ws + WS_SIN);
    float* F2 = (float*)(ws + WS_F2); float* LF = (float*)(ws + WS_LF); int* BLK = (int*)(ws + WS_BLK);
    bf16_t* WIN = (bf16_t*)(ws + WS_WIN); bf16_t* WAB = (bf16_t*)(ws + WS_WAB); bf16_t* WO = (bf16_t*)(ws + WS_WO); bf16_t* WRS = (bf16_t*)(ws + WS_WRS); bf16_t* WSD = (bf16_t*)(ws + WS_WSD);
    bf16_t* WEG = (bf16_t*)(ws + WS_WEG); bf16_t* WED = (bf16_t*)(ws + WS_WED); bf16_t* XN = (bf16_t*)(ws + WS_XN);
    bf16_t* QF = (bf16_t*)(ws + WS_QF); bf16_t* KF = (bf16_t*)(ws + WS_KF); bf16_t* VF = (bf16_t*)(ws + WS_VF); bf16_t* RQ = (bf16_t*)(ws + WS_RQ); bf16_t* RK = (bf16_t*)(ws + WS_RK);
    bf16_t* RV = (bf16_t*)(ws + WS_RV); bf16_t* SG = (bf16_t*)(ws + WS_SG); bf16_t* GA = (bf16_t*)(ws + WS_GA); bf16_t* GB = (bf16_t*)(ws + WS_GB);
    bf16_t* AO = (bf16_t*)(ws + WS_AO); bf16_t* MRG = (bf16_t*)(ws + WS_MRG); float* X1 = (float*)(ws + WS_X1); float* KVN = (float*)(ws + WS_KVN);
    float* SCORES = (float*)(ws + WS_SCORES); bf16_t* HS = (bf16_t*)(ws + WS_HS); int* LTOK = (int*)(ws + WS_LTOK); float* LW = (float*)(ws + WS_LW);
    bf16_t* HE = (bf16_t*)(ws + WS_HE); bf16_t* YS = (bf16_t*)(ws + WS_YS);

    hipMemsetAsync(ws + WS_CTL, 0, 1 * MiB, stream);
    hipMemsetAsync(WIN + (size_t)6664 * D_, 0, (size_t)(NIN - 6664) * D_ * 2, stream);
    const dim3 tb(32, 8);
    k_transpose<<<dim3(1536 / 32, 32, 1), tb, 0, stream>>>(w_in, 1024, 6664, 0, 1536, WIN, 1024, 0, 0, 0, 0, 0, 0);
    k_transpose<<<dim3(5120 / 32, 32, 1), tb, 0, stream>>>(w_in, 1024, 6664, 1544, 5120, WIN, 1024, 0, 1536, 0, 0, 0, 0);
    k_transpose<<<dim3(1, 32, 1), tb, 0, stream>>>(w_in, 1024, 6664, 1536, 8, WIN, 1024, 0, 6656, 0, 0, 0, 0);
    k_transpose<<<dim3(32, 16, 1), tb, 0, stream>>>(w_a, 512, 1024, 0, 1024, WAB, 1536, 0, 0, 0, 0, 0, 0);
    k_transpose<<<dim3(32, 32, 1), tb, 0, stream>>>(w_b, 1024, 1024, 0, 1024, WAB, 1536, 512, 0, 0, 0, 0, 0);
    k_transpose<<<dim3(32, 32, 1), tb, 0, stream>>>(w_out, 1024, 1024, 0, 1024, WO, 1024, 0, 0, 0, 0, 0, 0);
    k_transpose<<<dim3(8, 32, 1), tb, 0, stream>>>(w_router, 1024, 256, 0, 256, WRS, 1024, 0, 0, 0, 0, 0, 0);
    k_transpose<<<dim3(8, 32, 1), tb, 0, stream>>>(w_sg, 1024, 256, 0, 256, WRS, 1024, 0, 256, 32, 0, 0, 0);
    k_transpose<<<dim3(8, 32, 1), tb, 0, stream>>>(w_su, 1024, 256, 0, 256, WRS, 1024, 0, 256, 32, 1, 0, 0);
    k_transpose<<<dim3(32, 8, 1), tb, 0, stream>>>(w_sd, 256, 1024, 0, 1024, WSD, 256, 0, 0, 0, 0, 0, 0);
    k_transpose<<<dim3(8, 32, NE), tb, 0, stream>>>(w_eg, 1024, 256, 0, 256, WEG, 1024, 0, 0, 32, 0, (long)1024 * 256, (long)512 * 1024);
    k_transpose<<<dim3(8, 32, NE), tb, 0, stream>>>(w_eu, 1024, 256, 0, 256, WEG, 1024, 0, 0, 32, 1, (long)1024 * 256, (long)512 * 1024);
    k_transpose<<<dim3(32, 8, NE), tb, 0, stream>>>(w_ed, 256, 1024, 0, 1024, WED, 256, 0, 0, 0, 0, (long)256 * 1024, (long)1024 * 256);
    k_mod<<<(NBATCH * 6144 + 255) / 256, 256, 0, stream>>>(c, w_ada, b_ada, MOD);
    k_rope<<<S_ * 32 / 256, 256, 0, stream>>>(COS, SIN);
    k_norm_mod<<<T_ / 4, 256, 0, stream>>>(x, norm1_g, MOD, 0, 1024, XN);
    InprojPtrs ip{XN, WIN, QF, KF, VF, RQ, RK, RV, SG, GA, GB, LF, COS, SIN, b_forget};
    k_gemm_inproj<<<128 * (NIN / 128), 256, 0, stream>>>(ip);
    k_cumsum<<<32, 64, 0, stream>>>(LF, F2);
    k_fox_naive<<<T_ * 8 / 4, 256, 0, stream>>>(QF, KF, VF, F2, AO);
    k_ret_kv<<<1024, 256, 0, stream>>>(RK, RV, KVN);
    k_ret_scan<<<32 * 8192 / 256, 256, 0, stream>>>(KVN);
    k_ret_out<<<1024, 256, 0, stream>>>(RQ, RK, RV, KVN, ret_gn_g, SG, AO);
    DensePtrs da{AO, 1536, WAB, 1536, 512, 8, 0, MRG, GA, nullptr, nullptr, nullptr, nullptr};
    k_gemm_dense<<<128 * 8, 256, 0, stream>>>(da);
    DensePtrs db{AO + 512, 1536, WAB + 512, 1536, 1024, 8, 1, MRG, GB, nullptr, nullptr, nullptr, nullptr};
    k_gemm_dense<<<128 * 8, 256, 0, stream>>>(db);
    DensePtrs dout{MRG, 1024, WO, 1024, 1024, 8, 2, nullptr, nullptr, X1, x, MOD, nullptr};
    k_gemm_dense<<<128 * 8, 256, 0, stream>>>(dout);
    k_norm_mod<<<T_ / 4, 256, 0, stream>>>(X1, norm2_g, MOD, 3072, 4096, XN);
    DensePtrs dr{XN, 1024, WRS, 1024, 1024, 6, 3, nullptr, nullptr, SCORES, nullptr, nullptr, HS};
    k_gemm_dense<<<128 * 6, 256, 0, stream>>>(dr);
    DensePtrs ds{HS, 256, WSD, 256, 256, 8, 4, MRG, nullptr, nullptr, nullptr, nullptr, nullptr};
    k_gemm_dense<<<128 * 8, 256, 0, stream>>>(ds);
    k_route<<<T_ / 4, 256, 0, stream>>>(SCORES, router_bias, CNT, LTOK, LW);
    k_blocktable<<<1, 256, 0, stream>>>(CNT, BLK);
    MoePtrs mp{XN, WEG, WED, CNT, BLK, LTOK, LW, HE, YS};
    k_moe_up<<<1280 * 4, 256, 0, stream>>>(mp);
    k_moe_down<<<1280 * 8, 256, 0, stream>>>(mp);
    k_final<<<T_ / 4, 256, 0, stream>>>(X1, YS, MRG, MOD, final_g, out);
}
```

```cpp
#include <hip/hip_runtime.h>
#include <stdint.h>
#include <cstdio>

typedef unsigned short bf16_t;
typedef short bf16x8 __attribute__((ext_vector_type(8)));
typedef float f32x4 __attribute__((ext_vector_type(4)));

constexpr int T_ = 16384, D_ = 1024, S_ = 4096, NBATCH = 4;
constexpr int NIN = 6912;
constexpr int NE = 256, CAP = 16384, TOPK = 8;
constexpr float EPS = 1e-6f;
constexpr float LOG2E = 1.4426950408889634f;
constexpr float C2 = 0.125f * LOG2E;

constexpr size_t MiB = 1u << 20;
constexpr size_t WS_CTL = 0;
constexpr size_t WS_MOD = 1 * MiB;
constexpr size_t WS_COS = 1 * MiB + 256 * 1024;
constexpr size_t WS_SIN = WS_COS + 512 * 1024;
constexpr size_t WS_F2 = 2 * MiB + 512 * 1024;
constexpr size_t WS_LF = 3 * MiB;
constexpr size_t WS_BLK = 3 * MiB + 512 * 1024;
constexpr size_t WS_WIN = 8 * MiB;
constexpr size_t WS_WAB = 22 * MiB;
constexpr size_t WS_WO = 25 * MiB;
constexpr size_t WS_WRS = 27 * MiB;
constexpr size_t WS_WSD = 28 * MiB + 512 * 1024;
constexpr size_t WS_WEG = 32 * MiB;
constexpr size_t WS_WED = 288 * MiB;
constexpr size_t WS_XN = 416 * MiB;
constexpr size_t WS_QF = 448 * MiB, WS_KF = 464 * MiB, WS_VF = 480 * MiB, WS_RQ = 496 * MiB, WS_RK = 512 * MiB;
constexpr size_t WS_RV = 528 * MiB, WS_SG = 560 * MiB, WS_GA = 592 * MiB, WS_GB = 624 * MiB;
constexpr size_t WS_AO = 656 * MiB;
constexpr size_t WS_MRG = 704 * MiB;
constexpr size_t WS_X1 = 736 * MiB;
constexpr size_t WS_KVN = 800 * MiB;
constexpr size_t WS_SCORES = 832 * MiB;
constexpr size_t WS_HS = 848 * MiB;
constexpr size_t WS_LTOK = 860 * MiB;
constexpr size_t WS_LW = 876 * MiB;
constexpr size_t WS_HE = 892 * MiB;
constexpr size_t WS_YS = 448 * MiB;
constexpr size_t WS_END = 972 * MiB;

__device__ __forceinline__ float bf2f(bf16_t v) { return __uint_as_float(((unsigned)v) << 16); }
__device__ __forceinline__ bf16_t f2bf(float f) { unsigned u = __float_as_uint(f); return (bf16_t)((u + 0x7fffu + ((u >> 16) & 1u)) >> 16); }
__device__ __forceinline__ float sigmoidf_(float x) { return 1.0f / (1.0f + __expf(-x)); }
__device__ __forceinline__ float siluf_(float x) { return x / (1.0f + __expf(-x)); }
__device__ __forceinline__ float logsigmoidf_(float x) { return x >= 0.f ? -log1pf(expf(-x)) : x - log1pf(expf(x)); }
__device__ __forceinline__ float wave_sum(float v) {
#pragma unroll
    for (int o = 1; o < 64; o <<= 1) v += __shfl_xor(v, o);
    return v;
}

__device__ __forceinline__ void sincos_cw(float x, float& s, float& c) {
    int j = (int)(x * 1.27323954473516f); float y = (float)j; if (j & 1) { ++j; y += 1.f; }
    j &= 7; float ss = 1.f, cs = 1.f; if (j > 3) { ss = -1.f; cs = -1.f; j -= 4; } if (j > 1) cs = -cs;
    x = ((x - y * 0.78515625f) - y * 2.4187564849853515625e-4f) - y * 3.77489497744594108e-8f;
    const float z = x * x;
    const float ps = ((-1.9515295891e-4f * z + 8.3321608736e-3f) * z - 1.6666654611e-1f) * z * x + x;
    const float pc = ((2.443315711809948e-5f * z - 1.388731625493765e-3f) * z + 4.166664568298827e-2f) * z * z - 0.5f * z + 1.0f;
    if (j == 2) { s = ss * pc; c = cs * ps; } else { s = ss * ps; c = cs * pc; }
}
#define GAS __attribute__((address_space(1)))
#define LAS __attribute__((address_space(3)))
typedef unsigned v4u __attribute__((ext_vector_type(4)));
typedef unsigned v2u __attribute__((ext_vector_type(2)));
#define LDS_WAIT() asm volatile("s_waitcnt lgkmcnt(0)" ::: "memory")
#define VM_WAIT() asm volatile("s_waitcnt vmcnt(0)" ::: "memory")
typedef float f32x2_t __attribute__((ext_vector_type(2))); typedef __bf16 bf16x2_t __attribute__((ext_vector_type(2)));
__device__ __forceinline__ unsigned cvt_pk_bf16(float lo, float hi) { f32x2_t v = {lo, hi}; bf16x2_t b = __builtin_convertvector(v, bf16x2_t); return __builtin_bit_cast(unsigned, b); }
__device__ __forceinline__ float fast_sigmoid(float x) { return __builtin_amdgcn_rcpf(1.0f + __builtin_amdgcn_exp2f(-LOG2E * x)); }
__device__ __forceinline__ float fast_silu(float x) { return x * fast_sigmoid(x); }

__device__ __forceinline__ int lane_id_asm() { int l; asm volatile("v_mbcnt_lo_u32_b32 %0, -1, 0\n\tv_mbcnt_hi_u32_b32 %0, -1, %0" : "=v"(l)); return l; }
constexpr int NWAVES = 8;
constexpr int RING_OFF = 0, RING_BYTES = 131072;
constexpr int LDSCTL_OFF = RING_BYTES, MISC_OFF = LDSCTL_OFF + 320;
constexpr int LDS_BYTES = 147456;
constexpr int CW_BAR = 4096;
constexpr int GU_G_SH = 128;
constexpr int GU_G_E = 32;

namespace pg8 {
#define PG8_LAS __attribute__((address_space(3)))
typedef unsigned short bf16_t;
typedef short bf16x8 __attribute__((ext_vector_type(8)));
typedef float f32x4 __attribute__((ext_vector_type(4)));
typedef unsigned u32x4 __attribute__((ext_vector_type(4)));
constexpr int BM = 256, BK = 64, HALF = 128, HTB = HALF * BK * 2  , STAGE_BYTES = 8 * HTB, NXCD = 8, WGM = 8;

__host__ __device__ __forceinline__ int lds_byte(int r, int c) { const int st = (r >> 4) * 2 + (c >> 5), rr = r & 15, cc = c & 31, ob = rr * 64 + cc * 2; return st * 1024 + (ob ^ (((ob >> 9) & 1) << 5)); }
__host__ __device__ __forceinline__ void stage_rc(int b, int& R, int& C) { const int st = b / 1024, sb = b % 1024, swz = sb ^ (((sb >> 9) & 1) << 5); R = (st >> 1) * 16 + swz / 64; C = (st & 1) * 32 + (swz % 64) / 2; }
__host__ __device__ __forceinline__ int perm32(int rho) { const int n = rho >> 4, i = rho & 15; return 8 * (i >> 2) + 4 * n + (i & 3); }

struct Unit { int pm, pn; };
struct Gemm { const bf16_t* A; const bf16_t* Bt; int M, N, K, lda, ldb; };

struct StaticOrder {
    int nM, nN, nwg, G, c;
    __host__ __device__ void init(int M, int N, int G_, int c_) { nM = M / BM; nN = N / BM; nwg = nM * nN; G = G_; c = c_; }
    __host__ __device__ bool next(int i, Unit& u) const {
        const long L = (long)i * G + c; if (L >= nwg) return false;
        int wgid = (int)L; { const int q = nwg / NXCD, r = nwg % NXCD, xcd = wgid % NXCD, off = wgid / NXCD; wgid = (xcd < r ? xcd * (q + 1) : r * (q + 1) + (xcd - r) * q) + off; }
        const int nig = WGM * nN, gid = wgid / nig, fm = gid * WGM, gsz = (nM - fm) < WGM ? (nM - fm) : WGM;
        u.pm = fm + ((wgid % nig) % gsz); u.pn = (wgid % nig) / gsz; return true;
    }
    __device__ __forceinline__ void a_ready(const Unit&) const {}
    __device__ __forceinline__ void done(const Unit&) const {}
};

#define PG8_FOR_AI_M _Pragma("unroll") for (int ai = 0; ai < 2; ++ai) _Pragma("unroll") for (int m = 0; m < 4; ++m)
__device__ __forceinline__ u32x4 pack8(const f32x4& v0, const f32x4& v1) { u32x4 w; w.x = cvt_pk_bf16(v0[0], v0[1]); w.y = cvt_pk_bf16(v0[2], v0[3]); w.z = cvt_pk_bf16(v1[0], v1[1]); w.w = cvt_pk_bf16(v1[2], v1[3]); return w; }
template <int ACT> __device__ __forceinline__ f32x4 act4(f32x4 v, float sc) {
    if (ACT == 1) { v = v * sc; }
    else if (ACT == 2) { v[0] = fast_silu(v[0]); v[1] = fast_silu(v[1]); v[2] = fast_silu(v[2]); v[3] = fast_silu(v[3]); }
    else if (ACT == 3) { v[0] = fast_sigmoid(v[0]); v[1] = fast_sigmoid(v[1]); v[2] = fast_sigmoid(v[2]); v[3] = fast_sigmoid(v[3]); }
    return v;
}
struct EpiInproj {
    static constexpr bool PERM = true, AFTER_DRAIN = false, HAS_MID = false;
    bf16_t *QF, *KF, *VF, *RQ, *RK, *RV, *SG, *GA, *GB; float* LF; const float *COS, *SIN, *bforget;
    template <int ACT> __device__ __forceinline__ void plain(const f32x4 (&acc)[2][2][4][2], bf16_t* O, int ldc, int colt, float sc, int row0, int col8) const {
        PG8_FOR_AI_M { bf16_t* rowp = O + (size_t)(row0 + ai * HALF + m * 16) * ldc + colt + col8;
#pragma unroll
            for (int bj = 0; bj < 2; ++bj) *(u32x4*)(rowp + bj * HALF) = pack8(act4<ACT>(acc[ai][bj][m][0], sc), act4<ACT>(acc[ai][bj][m][1], sc)); }
    }
    __device__ __forceinline__ void operator()(const f32x4 (&acc)[2][2][4][2], const Unit& u, int wr, int wc, int fr, int fq) const {
        const int pn = u.pn, row0 = u.pm * BM + wr * 64 + fr, col8 = wc * 32 + 8 * fq;
        if (pn < 2) plain<1>(acc, QF, 512, pn * 256, C2, row0, col8);
        else if (pn < 4) plain<0>(acc, KF, 512, (pn - 2) * 256, 1.f, row0, col8);
        else if (pn < 6) plain<0>(acc, VF, 512, (pn - 4) * 256, 1.f, row0, col8);
        else if (pn < 10) {
            const bool isq = pn < 8; bf16_t* O = isq ? RQ : RK; const float sc = isq ? 1.f : 0.125f; const int hc = (4 * (pn & 1) + wc) * 64 + 8 * fq;
            PG8_FOR_AI_M { const int row = row0 + ai * HALF + m * 16, pos = row & (S_ - 1);
                f32x4 o1[2], o2[2];
#pragma unroll
                for (int n = 0; n < 2; ++n) { const f32x4 cs = *(const f32x4*)(COS + pos * 32 + 8 * fq + 4 * n), sn = *(const f32x4*)(SIN + pos * 32 + 8 * fq + 4 * n);
                    const f32x4 x1 = acc[ai][0][m][n], x2 = acc[ai][1][m][n]; o1[n] = (x1 * cs - x2 * sn) * sc; o2[n] = (x1 * sn + x2 * cs) * sc; }
                bf16_t* rowp = O + (size_t)row * 512 + hc; *(u32x4*)rowp = pack8(o1[0], o1[1]); *(u32x4*)(rowp + 32) = pack8(o2[0], o2[1]); }
        }
        else if (pn < 14) plain<0>(acc, RV, 1024, (pn - 10) * 256, 1.f, row0, col8);
        else if (pn < 18) plain<2>(acc, SG, 1024, (pn - 14) * 256, 1.f, row0, col8);
        else if (pn < 22) plain<3>(acc, GA, 1024, (pn - 18) * 256, 1.f, row0, col8);
        else if (pn < 26) plain<3>(acc, GB, 1024, (pn - 22) * 256, 1.f, row0, col8);
        else if (wc == 0 && fq == 0) {
            const f32x4 b0 = *(const f32x4*)bforget, b1 = *(const f32x4*)(bforget + 4);
            PG8_FOR_AI_M { const int row = row0 + ai * HALF + m * 16; f32x4 a = acc[ai][0][m][0] + b0, b = acc[ai][0][m][1] + b1;
#pragma unroll
                for (int e = 0; e < 4; ++e) { a[e] = logsigmoidf_(a[e]); b[e] = logsigmoidf_(b[e]); }
                *(f32x4*)(LF + (size_t)row * 8) = a; *(f32x4*)(LF + (size_t)row * 8 + 4) = b; }
        }
    }
};

__device__ __forceinline__ float bfe(const u32x4& w, int i) { const unsigned x = w[i >> 1]; return __uint_as_float((i & 1) ? (x & 0xffff0000u) : (x << 16)); }
struct EpiMerge {
    static constexpr bool PERM = true, AFTER_DRAIN = false, HAS_MID = true;
    bf16_t* O; const bf16_t* GA; const bf16_t* GB; int mid_tiles;
    __device__ __forceinline__ void mid(f32x4 (&acc)[2][2][4][2], const Unit& u, int wr, int wc, int fr, int fq) const {
        const int row0 = u.pm * BM + wr * 64 + fr, col0 = u.pn * BM + wc * 32 + 8 * fq;
        unsigned off0 = (unsigned)row0 * 1024u + (unsigned)col0; asm volatile("" : "+v"(off0));
        PG8_FOR_AI_M { const unsigned off = off0 + (unsigned)(ai * HALF + m * 16) * 1024u;
#pragma unroll
            for (int bj = 0; bj < 2; ++bj) { const u32x4 ga = *(const u32x4*)(GA + off + bj * HALF), gb = *(const u32x4*)(GB + off + bj * HALF);
#pragma unroll
                for (int n = 0; n < 2; ++n)
#pragma unroll
                    for (int e = 0; e < 4; ++e) acc[ai][bj][m][n][e] *= bfe(ga, 4 * n + e) * __builtin_amdgcn_rcpf(bfe(gb, 4 * n + e)); }
            asm volatile("" ::: "memory"); }
    }
    __device__ __forceinline__ void operator()(const f32x4 (&acc)[2][2][4][2], const Unit& u, int wr, int wc, int fr, int fq) const {
        const int row0 = u.pm * BM + wr * 64 + fr, col0 = u.pn * BM + wc * 32 + 8 * fq;
        PG8_FOR_AI_M { const size_t off = (size_t)(row0 + ai * HALF + m * 16) * 1024 + col0;
#pragma unroll
            for (int bj = 0; bj < 2; ++bj) { const u32x4 gb = *(const u32x4*)(GB + off + bj * HALF); f32x4 v0 = acc[ai][bj][m][0], v1 = acc[ai][bj][m][1];
#pragma unroll
                for (int e = 0; e < 4; ++e) { v0[e] *= bfe(gb, e); v1[e] *= bfe(gb, 4 + e); }
                *(u32x4*)(O + off + bj * HALF) = pack8(v0, v1); } }
    }
};
struct EpiX1 {
    static constexpr bool PERM = false, AFTER_DRAIN = false, HAS_MID = false;
    const float* X; const float* mod; float* O;
    __device__ __forceinline__ void operator()(const f32x4 (&acc)[2][2][4][2], const Unit& u, int wr, int wc, int fr, int fq) const {
        const int row0 = u.pm * BM + wr * 64 + fr, col0 = u.pn * BM + wc * 32 + 4 * fq; const float* gp = mod + (u.pm >> 4) * 6144 + 2048 + col0;
#pragma unroll
        for (int bj = 0; bj < 2; ++bj)
#pragma unroll
            for (int n = 0; n < 2; ++n) { const f32x4 gate = *(const f32x4*)(gp + bj * HALF + n * 16);
                PG8_FOR_AI_M { const size_t off = (size_t)(row0 + ai * HALF + m * 16) * 1024 + col0 + bj * HALF + n * 16; *(f32x4*)(O + off) = *(const f32x4*)(X + off) + gate * acc[ai][bj][m][n]; } }
    }
};
struct EpiRS {
    static constexpr bool PERM = true, AFTER_DRAIN = false, HAS_MID = false;
    float* SC; bf16_t* HS;
    __device__ __forceinline__ void operator()(const f32x4 (&acc)[2][2][4][2], const Unit& u, int wr, int wc, int fr, int fq) const {
        const int row0 = u.pm * BM + wr * 64 + fr, c8 = wc * 32 + 8 * fq;
        if (u.pn == 0) {
            PG8_FOR_AI_M { float* rp = SC + (size_t)(row0 + ai * HALF + m * 16) * 256 + c8;
#pragma unroll
                for (int bj = 0; bj < 2; ++bj)
#pragma unroll
                    for (int n = 0; n < 2; ++n) *(f32x4*)(rp + bj * HALF + 4 * n) = act4<3>(acc[ai][bj][m][n], 1.f); }
        } else {
            PG8_FOR_AI_M { bf16_t* rp = HS + (size_t)(row0 + ai * HALF + m * 16) * 256 + (u.pn - 1) * HALF + c8;
                *(u32x4*)rp = pack8(act4<2>(acc[ai][0][m][0], 1.f) * acc[ai][1][m][0], act4<2>(acc[ai][0][m][1], 1.f) * acc[ai][1][m][1]); }
        }
    }
};
template <int ldc> struct EpiPlain {
    static constexpr bool PERM = true, AFTER_DRAIN = false, HAS_MID = false;
    bf16_t* O;
    __device__ __forceinline__ void operator()(const f32x4 (&acc)[2][2][4][2], const Unit& u, int wr, int wc, int fr, int fq) const {
        const int row0 = u.pm * BM + wr * 64 + fr, col0 = u.pn * BM + wc * 32 + 8 * fq;
        PG8_FOR_AI_M { bf16_t* rowp = O + (size_t)(row0 + ai * HALF + m * 16) * ldc + col0;
#pragma unroll
            for (int bj = 0; bj < 2; ++bj) *(u32x4*)(rowp + bj * HALF) = pack8(acc[ai][bj][m][0], acc[ai][bj][m][1]); }
    }
};

template <class Epi, class Sched, bool ALIGN_EPI = false, bool SP2 = false>
__device__ __forceinline__ void gemm_phase(PG8_LAS unsigned char* lds, const Gemm g, const Sched& S, const Epi& E, const int wid) {
    const int lane = lane_id_asm(), tid = wid * 64 + lane, wr = wid >> 2, wc = wid & 3, fr = lane & 15, fq = lane >> 4;
    int K = g.K; asm volatile("" : "+s"(K));
    const int nt = K / BK;
    unsigned voffA[2], voffB[2];
#pragma unroll
    for (int i = 0; i < 2; ++i) { int R, C; stage_rc(tid * 16 + i * 8192, R, C); const int Rb = Epi::PERM ? ((R & ~31) + perm32(R & 31)) : R;
        voffA[i] = (unsigned)(R * g.lda + C) * 2u; voffB[i] = (unsigned)(Rb * g.ldb + C) * 2u; }
    const size_t kstep = (size_t)(BK * 2);
    const size_t hstepA = (size_t)HALF * g.lda * 2, hstepB = (size_t)HALF * g.ldb * 2;
    const size_t tstepA = 2 * hstepA, tstepB = 2 * hstepB;
    const unsigned ldsw = (unsigned)wid * 1024u;
    const int aoff = lds_byte(wr * 64 + fr, fq * 8), boff = lds_byte(wc * 32 + fr, fq * 8);
#define PG8_SA(b, h) (((b) * 2 + (h)) * HTB)
#define PG8_SB(b, h) ((4 + (b) * 2 + (h)) * HTB)
#define PG8_STAGE(bufoff, gbase, voff) do { _Pragma("unroll") for (int _i = 0; _i < 2; ++_i) \
        __builtin_amdgcn_global_load_lds((const unsigned*)((const char*)(gbase) + (voff)[_i]), (PG8_LAS unsigned*)(lds + (bufoff) + ldsw + _i * 8192), 16, 0, 0); } while (0)
#define PG8_LDA(dst, b, h) do { _Pragma("unroll") for (int m = 0; m < 4; ++m) _Pragma("unroll") for (int k = 0; k < 2; ++k) dst[m][k] = *(const PG8_LAS bf16x8*)(lds + PG8_SA(b, h) + aoff + m * 2048 + k * 1024); } while (0)
#define PG8_LDB(dst, b, h) do { _Pragma("unroll") for (int n = 0; n < 2; ++n) _Pragma("unroll") for (int k = 0; k < 2; ++k) dst[n][k] = *(const PG8_LAS bf16x8*)(lds + PG8_SB(b, h) + boff + n * 2048 + k * 1024); } while (0)
#define PG8_MMA(ai, bj, At, Bt) do { __builtin_amdgcn_s_setprio(1); _Pragma("unroll") for (int m = 0; m < 4; ++m) _Pragma("unroll") for (int n = 0; n < 2; ++n) _Pragma("unroll") for (int k = 0; k < 2; ++k) \
        acc[ai][bj][m][n] = __builtin_amdgcn_mfma_f32_16x16x32_bf16(Bt[n][k], At[m][k], acc[ai][bj][m][n], 0, 0, 0); __builtin_amdgcn_s_setprio(0); } while (0)
#define PG8_WAIT_V(n) asm volatile("s_waitcnt vmcnt(" #n ")" ::: "memory")
#define PG8_WAIT_L(n) asm volatile("s_waitcnt lgkmcnt(" #n ")" ::: "memory")
#define PG8_BAR __builtin_amdgcn_s_barrier()
#define PG8_SCHED __builtin_amdgcn_sched_barrier(0)
    Unit cur, nxt; int ui = 0;
    if (!S.next(0, cur)) return;
    f32x4 acc[2][2][4][2];
#pragma unroll
    for (int a = 0; a < 2; ++a)
#pragma unroll
        for (int b = 0; b < 2; ++b)
#pragma unroll
            for (int m = 0; m < 4; ++m)
#pragma unroll
                for (int n = 0; n < 2; ++n) acc[a][b][m][n] = (f32x4){0.f, 0.f, 0.f, 0.f};
    bf16x8 At[4][2], B0[2][2], B1[2][2];
    const char* cA = (const char*)g.A + (size_t)cur.pm * tstepA; const char* cB = (const char*)g.Bt + (size_t)cur.pn * tstepB;
    S.a_ready(cur);
    if constexpr (SP2) {
        PG8_STAGE(PG8_SB(0, 0), cB, voffB); PG8_STAGE(PG8_SB(0, 1), cB + hstepB, voffB); PG8_STAGE(PG8_SA(0, 0), cA, voffA); PG8_STAGE(PG8_SA(0, 1), cA + hstepA, voffA);
        if (wr == 1) PG8_BAR;
        PG8_WAIT_V(2); PG8_BAR;
        PG8_STAGE(PG8_SB(1, 0), cB + kstep, voffB); PG8_STAGE(PG8_SA(1, 0), cA + kstep, voffA); PG8_STAGE(PG8_SB(1, 1), cB + hstepB + kstep, voffB);
        PG8_WAIT_V(6); PG8_BAR;
    } else {
        PG8_STAGE(PG8_SB(0, 0), cB, voffB); PG8_STAGE(PG8_SA(0, 0), cA, voffA); PG8_STAGE(PG8_SB(0, 1), cB + hstepB, voffB); PG8_STAGE(PG8_SA(0, 1), cA + hstepA, voffA);
        if (wr == 1) PG8_BAR;
        PG8_WAIT_V(4); PG8_BAR;
        PG8_STAGE(PG8_SB(1, 0), cB + kstep, voffB); PG8_STAGE(PG8_SA(1, 0), cA + kstep, voffA); PG8_STAGE(PG8_SB(1, 1), cB + hstepB + kstep, voffB);
        PG8_WAIT_V(6); PG8_BAR;
    }
    for (;;) {
        const bool has_next = S.next(ui + 1, nxt);
        const char* nA = has_next ? (const char*)g.A + (size_t)nxt.pm * tstepA : cA; const char* nB = has_next ? (const char*)g.Bt + (size_t)nxt.pn * tstepB : cB;
        for (int t = 0; t < nt; t += 2) {
            const bool last = (t == nt - 2);
            const char* a1 = cA + (size_t)(t + 1) * kstep;
            const char* a2 = last ? nA : cA + (size_t)(t + 2) * kstep; const char* b2 = last ? nB : cB + (size_t)(t + 2) * kstep;
            const char* a3 = a2 + kstep; const char* b3 = b2 + kstep;
            if (last && has_next) S.a_ready(nxt);
            if constexpr (SP2) {
            PG8_LDB(B0, 0, 0); PG8_LDB(B1, 0, 1); PG8_SCHED; PG8_LDA(At, 0, 0); PG8_STAGE(PG8_SA(1, 1), a1 + hstepA, voffA);
            PG8_WAIT_V(8); PG8_WAIT_L(0); PG8_BAR; PG8_MMA(0, 0, At, B0); PG8_MMA(0, 1, At, B1); PG8_BAR; PG8_SCHED;
            PG8_LDA(At, 0, 1); PG8_STAGE(PG8_SB(0, 0), b2, voffB); PG8_STAGE(PG8_SB(0, 1), b2 + hstepB, voffB); PG8_STAGE(PG8_SA(0, 0), a2, voffA);
            PG8_WAIT_V(8); PG8_WAIT_L(0); PG8_BAR; PG8_MMA(1, 0, At, B0); PG8_MMA(1, 1, At, B1); PG8_BAR; PG8_SCHED;
            PG8_LDB(B0, 1, 0); PG8_LDB(B1, 1, 1); PG8_SCHED; PG8_LDA(At, 1, 0); PG8_STAGE(PG8_SA(0, 1), a2 + hstepA, voffA);
            PG8_WAIT_V(8); PG8_WAIT_L(0); PG8_BAR; PG8_MMA(0, 0, At, B0); PG8_MMA(0, 1, At, B1); PG8_BAR; PG8_SCHED;
            PG8_LDA(At, 1, 1); PG8_STAGE(PG8_SB(1, 0), b3, voffB); PG8_STAGE(PG8_SB(1, 1), b3 + hstepB, voffB); PG8_STAGE(PG8_SA(1, 0), a3, voffA);
            PG8_WAIT_V(8); PG8_WAIT_L(0); PG8_BAR; PG8_MMA(1, 0, At, B0); PG8_MMA(1, 1, At, B1); PG8_BAR; PG8_SCHED;
            } else {
            PG8_LDB(B0, 0, 0); PG8_SCHED; PG8_LDA(At, 0, 0); PG8_STAGE(PG8_SA(1, 1), a1 + hstepA, voffA);
            PG8_WAIT_L(8); PG8_BAR; PG8_WAIT_L(0); PG8_MMA(0, 0, At, B0); PG8_BAR; PG8_SCHED;
            PG8_LDB(B1, 0, 1); PG8_STAGE(PG8_SB(0, 0), b2, voffB);
            PG8_BAR; PG8_WAIT_L(0); PG8_MMA(0, 1, At, B1); PG8_BAR;
            PG8_LDA(At, 0, 1); PG8_STAGE(PG8_SA(0, 0), a2, voffA);
            PG8_BAR; PG8_WAIT_L(0); PG8_MMA(1, 0, At, B0); PG8_BAR; PG8_SCHED;
            PG8_STAGE(PG8_SB(0, 1), b2 + hstepB, voffB);
            PG8_WAIT_V(6); PG8_BAR; PG8_MMA(1, 1, At, B1); PG8_BAR;
            PG8_LDB(B0, 1, 0); PG8_SCHED; PG8_LDA(At, 1, 0); PG8_STAGE(PG8_SA(0, 1), a2 + hstepA, voffA);
            PG8_WAIT_L(8); PG8_BAR; PG8_WAIT_L(0); PG8_MMA(0, 0, At, B0); PG8_BAR; PG8_SCHED;
            PG8_LDB(B1, 1, 1); PG8_STAGE(PG8_SB(1, 0), b3, voffB);
            PG8_BAR; PG8_WAIT_L(0); PG8_MMA(0, 1, At, B1); PG8_BAR;
            PG8_LDA(At, 1, 1); PG8_STAGE(PG8_SA(1, 0), a3, voffA);
            PG8_BAR; PG8_WAIT_L(0); PG8_MMA(1, 0, At, B0); PG8_BAR; PG8_SCHED;
            PG8_STAGE(PG8_SB(1, 1), b3 + hstepB, voffB);
            PG8_WAIT_V(6); PG8_BAR; PG8_MMA(1, 1, At, B1); PG8_BAR;
            }
            if constexpr (Epi::HAS_MID) { if (t + 2 == E.mid_tiles) E.mid(acc, cur, wr, wc, fr, fq); }
        }
        if constexpr (ALIGN_EPI) { if (wr == 0) PG8_BAR; }
        if constexpr (!Epi::AFTER_DRAIN) { E(acc, cur, wr, wc, fr, fq); S.done(cur); }
        if (!has_next) break;
#pragma unroll
        for (int a = 0; a < 2; ++a)
#pragma unroll
            for (int b = 0; b < 2; ++b)
#pragma unroll
                for (int m = 0; m < 4; ++m)
#pragma unroll
                    for (int n = 0; n < 2; ++n) acc[a][b][m][n] = (f32x4){0.f, 0.f, 0.f, 0.f};
        cur = nxt; cA = nA; cB = nB; ++ui;
        if constexpr (ALIGN_EPI) { if (wr == 1) PG8_BAR; }
    }
    PG8_WAIT_V(0);
    if constexpr (!ALIGN_EPI) { if (wr == 0) PG8_BAR; }
    PG8_BAR;
    if constexpr (Epi::AFTER_DRAIN) { E.fused(acc, cur, wr, wc, fr, fq, lds, wid, lane); S.done(cur); }
#undef PG8_SA
#undef PG8_SB
#undef PG8_STAGE
#undef PG8_LDA
#undef PG8_LDB
#undef PG8_MMA
#undef PG8_WAIT_V
#undef PG8_WAIT_L
#undef PG8_BAR
#undef PG8_SCHED
}
}

#define XB_TMO      128
#define XB_XCNT(j)  (256  + 64 * (j))
#define XB_XSUB(j)  (1280 + 64 * (j))
#define XB_XGEN(j)  (2304 + 64 * (j))
#define XB_TOP      3328
#define XB_TOPGEN   3392
#define XCD_BAR_WORDS 3456
#define XB_SPIN_CAP (1u << 18)

__device__ __forceinline__ unsigned xb_ld(unsigned* p)              { return __hip_atomic_load(p, __ATOMIC_RELAXED, __HIP_MEMORY_SCOPE_AGENT); }
__device__ __forceinline__ unsigned xb_add(unsigned* p, unsigned v) { return __hip_atomic_fetch_add(p, v, __ATOMIC_RELAXED, __HIP_MEMORY_SCOPE_AGENT); }
__device__ __forceinline__ unsigned xb_xcc_id() { return (unsigned)__builtin_amdgcn_s_getreg((3 << 11) | 20) & 0xFu; }
#define XB_SPIN(cond, bar) do { unsigned _sp = 0; while (cond) { __builtin_amdgcn_s_sleep(1); \
    if ((++_sp & 255u) == 0u) { if (xb_ld(&(bar)[XB_TMO])) break; if (_sp > XB_SPIN_CAP) { atomicAdd(&(bar)[XB_TMO], 1u); break; } } } } while (0)

struct XcdBarrier {
    unsigned* bar; unsigned x;
    volatile LAS unsigned* st;
};

__device__ __forceinline__ XcdBarrier xcd_barrier_post(unsigned* bar, volatile LAS unsigned* st) {
    XcdBarrier b; b.bar = bar; b.x = xb_xcc_id(); b.st = st;
    if (threadIdx.x == 0) (void)xb_add(&bar[XB_XCNT(b.x)], 1u);
    return b;
}
__device__ __forceinline__ void xcd_barrier_complete(unsigned* bar, unsigned x, unsigned& nloc, unsigned& nx) {
    const unsigned G = gridDim.x * gridDim.y * gridDim.z;
    unsigned sum, cnt, mine, sp = 0u;
    for (;;) {
        sum = 0u; cnt = 0u; mine = 0u;
#pragma unroll
        for (unsigned j = 0; j < 16; ++j) { const unsigned c = xb_ld(&bar[XB_XCNT(j)]); sum += c; cnt += (c > 0u) ? 1u : 0u; mine = (j == x) ? c : mine; }
        if (sum == G) break;
        __builtin_amdgcn_s_sleep(1);
        if ((++sp & 255u) == 0u) { if (xb_ld(&bar[XB_TMO])) break; if (sp > XB_SPIN_CAP) { atomicAdd(&bar[XB_TMO], 1u); break; } }
    }
    nloc = mine > 0u ? mine : 1u; nx = cnt > 0u ? cnt : 1u;
}

__device__ __forceinline__ void xcd_barrier(const XcdBarrier& b, const int wave) {
    asm volatile("s_waitcnt vmcnt(0)" ::: "memory");
    __syncthreads();
    if (wave == 0 && lane_id_asm() == 0) {
        unsigned* bar = b.bar;
        __builtin_amdgcn_s_waitcnt(0);
        unsigned nloc = b.st[0], nx = b.st[1];
        if (nloc == 0u) { xcd_barrier_complete(bar, b.x, nloc, nx); b.st[0] = nloc; b.st[1] = nx; }
        const unsigned old = xb_add(&bar[XB_XSUB(b.x)], 1u);
        const unsigned gen = old / nloc;
        if (old + 1u == (gen + 1u) * nloc) {
            __builtin_amdgcn_fence(__ATOMIC_RELEASE, "agent");
            asm volatile("s_waitcnt vmcnt(0)" ::: "memory");
            const unsigned og = xb_add(&bar[XB_TOP], 1u);
            const unsigned tg = og / nx;
            if (og + 1u == (tg + 1u) * nx) xb_add(&bar[XB_TOPGEN], 1u);
            else XB_SPIN(xb_ld(&bar[XB_TOPGEN]) == tg, bar);
            __builtin_amdgcn_fence(__ATOMIC_ACQUIRE, "agent");
            xb_add(&bar[XB_XGEN(b.x)], 1u);
            asm volatile("s_waitcnt vmcnt(0)" ::: "memory");
        } else {
            XB_SPIN(xb_ld(&bar[XB_XGEN(b.x)]) == gen, bar);
            __builtin_amdgcn_fence(__ATOMIC_ACQUIRE, "agent");
            asm volatile("s_waitcnt vmcnt(0)" ::: "memory");
        }
    }
    __syncthreads();
}

#include <hip/hip_bf16.h>
#include <cmath>
namespace attn_body {
using bf16=__hip_bfloat16;
using bf16x8=__attribute__((ext_vector_type(8)))short;
using s16x4=__attribute__((ext_vector_type(4)))short;
using f32x16=__attribute__((ext_vector_type(16)))float;
using f32x4v=__attribute__((ext_vector_type(4)))float;
using u32x4=__attribute__((ext_vector_type(4)))unsigned;
constexpr int BATCH=4,NHEAD=8,SEQ=4096,D=64,DM=NHEAD*D,OPITCH=1536;
constexpr int NW=8,QBLK=32,QB=QBLK*NW,KVBLK=64,NQB=SEQ/QB;
constexpr int ATTN_PITCH=DM, ATTN_UNIT_ROWS=QB;
__device__ __forceinline__ int crow(int r,int hi){return (r&3)+8*(r>>2)+4*hi;}
#define SBAR() __builtin_amdgcn_sched_barrier(0)
__device__ __forceinline__ void cmask(f32x16&p0,f32x16&p1,int jb,int qrel,int hi){
  const float NEG=-INFINITY; int kb=64*jb+4*hi;
  #pragma unroll
  for(int r=0;r<16;++r){int kv=kb+(r&3)+8*(r>>2); if(kv>qrel)p0[r]=NEG; if(kv+32>qrel)p1[r]=NEG;}
}

constexpr int NSLOT=3, SLOTB=8192;
constexpr int LDS_K=0, LDS_V=NSLOT*SLOTB, LDS_WS=2*NSLOT*SLOTB, LDS_OST=LDS_WS+NW*64*4, LDS_F=LDS_OST+NW*4096, LDS_BYTES=LDS_F+SEQ*4;
constexpr float C2=0.125f*1.4426950408889634f;
__device__ __forceinline__ void glds16(const void*gsrc,unsigned lds_dst){unsigned keep;
  asm volatile("s_mov_b32 %0, m0\n\ts_mov_b32 m0, %2\n\ts_nop 0\n\tglobal_load_lds_dwordx4 %1, off\n\ts_mov_b32 m0, %0":"=&s"(keep):"v"(gsrc),"s"(lds_dst):"memory");}
__device__ __forceinline__ float max3f(float a,float b,float c){float r;asm("v_max3_f32 %0, %1, %2, %3":"=v"(r):"v"(a),"v"(b),"v"(c));return r;}
__device__ __forceinline__ float max2f(float a,float b){float r;asm("v_max_f32_e32 %0, %1, %2":"=v"(r):"v"(a),"v"(b));return r;}
__device__ __forceinline__ float fadd_s(float a,float b){float r;asm("v_add_f32_e32 %0, %1, %2":"=v"(r):"v"(a),"v"(b));return r;}
__device__ __forceinline__ float fsub_s(float a,float b){float r;asm("v_sub_f32_e32 %0, %1, %2":"=v"(r):"v"(a),"v"(b));return r;}
typedef float f32x2_t __attribute__((ext_vector_type(2))); typedef __bf16 bf16x2_t __attribute__((ext_vector_type(2)));
__device__ __forceinline__ unsigned cvtpk_s(float lo,float hi){f32x2_t v={lo,hi};bf16x2_t b=__builtin_convertvector(v,bf16x2_t);return __builtin_bit_cast(unsigned,b);}
#define WAIT_BAR(N) asm volatile("s_waitcnt vmcnt(" #N ") lgkmcnt(0)\n\ts_barrier":::"memory")

__device__ __forceinline__ void qkt(f32x16&p0,f32x16&p1,const char*Kslot,const bf16x8*qr,int r32,int hi){
  const char*kb=Kslot+hi*1024+r32*16;
  #pragma unroll
  for(int d0=0;d0<4;++d0){
    const bf16x8 b0=*reinterpret_cast<const bf16x8*>(kb+d0*2048);
    const bf16x8 b1=*reinterpret_cast<const bf16x8*>(kb+d0*2048+512);
    p0=__builtin_amdgcn_mfma_f32_32x32x16_bf16(b0,qr[d0],p0,0,0,0);p1=__builtin_amdgcn_mfma_f32_32x32x16_bf16(b1,qr[d0],p1,0,0,0);}
}
typedef __attribute__((address_space(3))) const char* lds_cptr;
typedef short v4i16_t __attribute__((ext_vector_type(4)));
__device__ __forceinline__ void kload8(bf16x8*kf,lds_cptr kp){
  kf[0]=*(const __attribute__((address_space(3))) bf16x8*)(kp);      kf[1]=*(const __attribute__((address_space(3))) bf16x8*)(kp+512);
  kf[2]=*(const __attribute__((address_space(3))) bf16x8*)(kp+2048); kf[3]=*(const __attribute__((address_space(3))) bf16x8*)(kp+2560);
  kf[4]=*(const __attribute__((address_space(3))) bf16x8*)(kp+4096); kf[5]=*(const __attribute__((address_space(3))) bf16x8*)(kp+4608);
  kf[6]=*(const __attribute__((address_space(3))) bf16x8*)(kp+6144); kf[7]=*(const __attribute__((address_space(3))) bf16x8*)(kp+6656);
}
__device__ __forceinline__ void kload2(bf16x8*kf,lds_cptr kp,int j){ kf[2*j]=*(const __attribute__((address_space(3))) bf16x8*)(kp+j*2048); kf[2*j+1]=*(const __attribute__((address_space(3))) bf16x8*)(kp+j*2048+512); }
__device__ __forceinline__ s16x4 vtr(lds_cptr p){ return __builtin_bit_cast(s16x4,__builtin_amdgcn_ds_read_tr16_b64_v4i16((__attribute__((address_space(3))) v4i16_t*)p)); }
__device__ __forceinline__ float rowmax(const f32x16&p0,const f32x16&p1){
  float a=max3f(p0[0],p0[1],p1[0]),b=max3f(p0[2],p0[3],p1[1]);a=max3f(a,p1[2],p1[3]);
  #pragma unroll
  for(int r=4;r<16;r+=4){a=max3f(a,p0[r],p0[r+1]);b=max3f(b,p0[r+2],p0[r+3]);a=max3f(a,p1[r],p1[r+1]);b=max3f(b,p1[r+2],p1[r+3]);}
  const float m=max2f(a,b);
  auto rr=__builtin_amdgcn_permlane32_swap(__float_as_uint(m),__float_as_uint(m),false,false);
  return max2f(__uint_as_float(rr[0]),__uint_as_float(rr[1]));
}
__device__ __forceinline__ void pv(f32x16*o,int vb,bf16x8 pa0,bf16x8 pa1,bf16x8 pa2,bf16x8 pa3){
  #pragma unroll
  for(int d0=0;d0<2;++d0){s16x4 lo[4],hi[4];
    #pragma unroll
    for(int ks=0;ks<4;++ks){
      asm volatile("ds_read_b64_tr_b16 %0,%1 offset:%c2":"=&v"(lo[ks]):"v"(vb),"i"(d0*4096+ks*1024):"memory");
      asm volatile("ds_read_b64_tr_b16 %0,%1 offset:%c2":"=&v"(hi[ks]):"v"(vb),"i"(d0*4096+ks*1024+512):"memory");}
    asm volatile("s_waitcnt lgkmcnt(0)":::"memory");SBAR();
    #define PK(k) (bf16x8){lo[k][0],lo[k][1],lo[k][2],lo[k][3],hi[k][0],hi[k][1],hi[k][2],hi[k][3]}
    o[d0]=__builtin_amdgcn_mfma_f32_32x32x16_bf16(pa0,PK(0),o[d0],0,0,0);
    o[d0]=__builtin_amdgcn_mfma_f32_32x32x16_bf16(pa1,PK(1),o[d0],0,0,0);
    o[d0]=__builtin_amdgcn_mfma_f32_32x32x16_bf16(pa2,PK(2),o[d0],0,0,0);
    o[d0]=__builtin_amdgcn_mfma_f32_32x32x16_bf16(pa3,PK(3),o[d0],0,0,0);
    #undef PK
  }
}

#ifndef ATTN_STORE16
#define ATTN_STORE16(p,v) (*(u32x4*)(p)=(v))
#endif
template<int THRL> __device__ __forceinline__ void attn_unit(int b,int h,int qb,const bf16*Q,const bf16*__restrict__ K,const bf16*__restrict__ V,bf16*O,const float*__restrict__ F2bh,char*shm,const int wid){
  const int lane=lane_id_asm(),tid=wid*64+lane,r32=lane&31,hi=lane>>5;
  const long rowbase=(long)b*SEQ; const int q0=qb*QB;
  const bf16*Qw=Q+(rowbase+q0+wid*QBLK)*DM+h*D;
  const bf16*Kh=K+rowbase*DM+h*D,*Vh=V+rowbase*DM+h*D;
  const unsigned lds0=(unsigned)(uintptr_t)shm;
  float*wsf=(float*)(shm+LDS_WS)+wid*64;
  const bf16*ksrc=Kh+(long)lane*DM+wid*8;
  const bf16*vsrc=Vh+(long)(16*(wid&3)+(lane>>2))*DM+(wid>>2)*32+(lane&3)*8;
  const unsigned kdst=lds0+LDS_K+wid*1024, vdst=lds0+LDS_V+wid*1024;
  #define DMA_K(t,slot) glds16(ksrc+(long)(t)*KVBLK*DM,(unsigned)__builtin_amdgcn_readfirstlane(kdst+(slot)))
  #define DMA_V(t,slot) glds16(vsrc+(long)(t)*KVBLK*DM,(unsigned)__builtin_amdgcn_readfirstlane(vdst+(slot)))
  const int vb0=(int)(lds0+LDS_V)+((lane>>4)&1)*32+(lane&3)*8+(4*hi+((lane&15)>>2))*64;
  const char*Kbase=shm+LDS_K; bf16x8 kf[8];
  const lds_cptr shm3=(lds_cptr)shm; const lds_cptr kp0=shm3+LDS_K+hi*1024+r32*16; const lds_cptr vp0=shm3+LDS_V+((lane>>4)&1)*32+(lane&3)*8+(4*hi+((lane&15)>>2))*64;
  const int NT=(q0+QB)/KVBLK;
  typedef __attribute__((address_space(3))) f32x4v lds_f4; typedef __attribute__((address_space(3))) const f32x4v lds_cf4;
  { const int nk4=(q0+QB)>>2; const f32x4v*src=(const f32x4v*)F2bh; lds_f4*dstF=(lds_f4*)((__attribute__((address_space(3))) char*)shm+LDS_F);
    for(int i=tid;i<nk4;i+=NW*64)dstF[i]=src[i]; }
  const float fq2=F2bh[q0+wid*QBLK+r32];
  lds_cf4*const fkp=(lds_cf4*)((__attribute__((address_space(3))) const char*)shm+LDS_F)+hi;
  #define FINIT(P,t,half) do{ lds_cf4*fp_=fkp+16*(t)+8*(half); const float base_=fq2-mhat; _Pragma("unroll") for(int g_=0;g_<4;++g_){ const f32x4v a_=fp_[2*g_]; \
      _Pragma("unroll") for(int e_=0;e_<4;++e_) P[4*g_+e_]=base_-a_[e_]; } }while(0)
  DMA_K(0,0);DMA_V(0,0);DMA_K(1,SLOTB);
  bf16x8 qr[4];
  #pragma unroll
  for(int d0=0;d0<4;++d0)qr[d0]=*reinterpret_cast<const bf16x8*>(&Qw[(long)r32*DM+d0*16+hi*8]);
  float mhat=0.f,l_reg=0.f;f32x16 o[2];o[0]=f32x16{};o[1]=f32x16{};
  const int qrel=wid*QBLK+r32;
  #define CMASK(P0,P1,t) do{int jb_=(t)-(NT-4); if(jb_>=0)cmask(P0,P1,jb_,qrel,hi);}while(0)
  bool resc=false;
  #define START(P0,P1) do{ const float rm=rowmax(P0,P1); resc=false; \
    { const float dl=rm; mhat=fadd_s(mhat,dl); \
      _Pragma("unroll") for(int r=0;r<16;++r){P0[r]=fsub_s(P0[r],dl);P1[r]=fsub_s(P1[r],dl);} \
      } \
    _Pragma("unroll") for(int r=0;r<16;++r)P0[r]=__builtin_amdgcn_exp2f(P0[r]); }while(0)
  #define RESC() do{ if(resc){ asm volatile("s_waitcnt lgkmcnt(0)":::"memory"); \
      _Pragma("unroll") for(int d_=0;d_<2;++d_) _Pragma("unroll") for(int r=0;r<16;++r)o[d_][r]*=wsf[crow(r,hi)]; } }while(0)
  f32x16 pA0,pA1,pB0,pB1;
  int sl_prev=0,sl_cur=0,sl_next=SLOTB;
  #define ROT() do{sl_prev=sl_cur;sl_cur=sl_next;sl_next=(sl_next==(NSLOT-1)*SLOTB)?0:sl_next+SLOTB;}while(0)
  DMA_K(2,2*SLOTB);
  WAIT_BAR(3);
  FINIT(pA0,0,0);FINIT(pA1,0,1);qkt(pA0,pA1,Kbase,qr,r32,hi);asm volatile("s_nop 15\n\ts_nop 7":"+v"(pA0),"+v"(pA1));CMASK(pA0,pA1,0);
  START(pA0,pA1);
  _Pragma("unroll") for(int r=0;r<16;++r)pA1[r]=__builtin_amdgcn_exp2f(pA1[r]);
  WAIT_BAR(0);
  DMA_K(3,0);DMA_V(1,SLOTB);
  ROT();
  kload8(kf,kp0+sl_cur);
  WAIT_BAR(2);
  s16x4 vlo[8],vhi[8]; u32x4 pw0,pw1,pw2,pw3;
  #define PKW(P,B) cvtpk_s(P[B],P[B+1])
  #define PAF(k) __builtin_bit_cast(bf16x8,pw##k)
  #define VFR(i) (bf16x8){vlo[i][0],vlo[i][1],vlo[i][2],vlo[i][3],vhi[i][0],vhi[i][1],vhi[i][2],vhi[i][3]}
  #define PIN(x) asm volatile("":"+v"(x))
  #define MX3(a,b,c) __builtin_fmaxf(__builtin_fmaxf((a),(b)),(c))
  #define GAPA(MF,A0,A1,A2,A3,W0,W1,PW) do{ MF; sacc+=A0; sacc+=A1; sacc+=A2; sacc+=A3; PIN(sacc); W0; W1; PIN(PW); SBAR(); }while(0)
  #define EX(v) __builtin_amdgcn_exp2f(v)
  #define GAPB(MF,X,B) do{ MF; X[B]=EX(X[B]); X[B+1]=EX(X[B+1]); X[B+2]=EX(X[B+2]); X[B+3]=EX(X[B+3]); PIN(X); SBAR(); }while(0)
  #define VRD(i) do{ vlo[i]=vtr(vp_+(((i)>>2)*4096+((i)&3)*1024)); vhi[i]=vtr(vp_+(((i)>>2)*4096+((i)&3)*1024+512)); }while(0)
  #define KRD(G,j) do{ if(G){ kload2(kf,kp0+sl_next,j); SBAR(); } }while(0)
  #define STEP(C0,C1,P0,P1,t,GK,GV,GL) do{ SBAR(); \
    const lds_cptr vp_=vp0+sl_prev; \
    FINIT(C0,t,0); SBAR(); VRD(0); SBAR(); float sacc=(P0[0]+P0[1]); \
    GAPA(C0=__builtin_amdgcn_mfma_f32_32x32x16_bf16(kf[0],qr[0],C0,0,0,0), P0[2],P0[3],P0[4],P0[5],     pw0[0]=PKW(P0,0), pw0[1]=PKW(P0,2), pw0); \
    FINIT(C1,t,1); SBAR(); VRD(4); SBAR(); GAPA(C1=__builtin_amdgcn_mfma_f32_32x32x16_bf16(kf[1],qr[0],C1,0,0,0), P0[6],P0[7],P0[8],P0[9],     pw0[2]=PKW(P0,4), pw0[3]=PKW(P0,6), pw0); \
    VRD(1); SBAR(); GAPA(C0=__builtin_amdgcn_mfma_f32_32x32x16_bf16(kf[2],qr[1],C0,0,0,0),   P0[10],P0[11],P0[12],P0[13], pw1[0]=PKW(P0,8), pw1[1]=PKW(P0,10), pw1); \
    VRD(5); SBAR(); GAPA(C1=__builtin_amdgcn_mfma_f32_32x32x16_bf16(kf[3],qr[1],C1,0,0,0),   P0[14],P0[15],P1[0],P1[1],   pw1[2]=PKW(P0,12),pw1[3]=PKW(P0,14), pw1); \
    VRD(2); SBAR(); GAPA(C0=__builtin_amdgcn_mfma_f32_32x32x16_bf16(kf[4],qr[2],C0,0,0,0),   P1[2],P1[3],P1[4],P1[5],     pw2[0]=PKW(P1,0), pw2[1]=PKW(P1,2), pw2); \
    VRD(6); SBAR(); GAPA(C1=__builtin_amdgcn_mfma_f32_32x32x16_bf16(kf[5],qr[2],C1,0,0,0),   P1[6],P1[7],P1[8],P1[9],     pw2[2]=PKW(P1,4), pw2[3]=PKW(P1,6), pw2); \
    VRD(3); SBAR(); GAPA(C0=__builtin_amdgcn_mfma_f32_32x32x16_bf16(kf[6],qr[3],C0,0,0,0),   P1[10],P1[11],P1[12],P1[13], pw3[0]=PKW(P1,8), pw3[1]=PKW(P1,10), pw3); \
    VRD(7); SBAR(); GAPA(C1=__builtin_amdgcn_mfma_f32_32x32x16_bf16(kf[7],qr[3],C1,0,0,0),   P1[14],P1[15],0.f,0.f,       pw3[2]=PKW(P1,12),pw3[3]=PKW(P1,14), pw3); \
    l_reg+=sacc; \
    if(GK){DMA_K((t)+3,sl_cur);} if(GV){DMA_V((t)+1,sl_next);} \
    CMASK(C0,C1,t); \
    { float a=MX3(C0[0],C0[1],C1[0]),b=MX3(C0[2],C0[3],C1[1]); a=MX3(a,C1[2],C1[3]); \
      _Pragma("unroll") for(int r=4;r<16;r+=4){a=MX3(a,C0[r],C0[r+1]);b=MX3(b,C0[r+2],C0[r+3]);a=MX3(a,C1[r],C1[r+1]);b=MX3(b,C1[r+2],C1[r+3]);} \
      float rm=__builtin_fmaxf(a,b); { auto rr=__builtin_amdgcn_permlane32_swap(__float_as_uint(rm),__float_as_uint(rm),false,false); rm=__builtin_fmaxf(__uint_as_float(rr[0]),__uint_as_float(rr[1])); } \
      resc=false; \
      if(__builtin_expect(__any(rm>(float)THRL),0)){ const float dl=__builtin_fmaxf(rm,0.f); mhat+=dl; \
        _Pragma("unroll") for(int r=0;r<16;++r){C0[r]-=dl;C1[r]-=dl;} \
        const float f=__builtin_amdgcn_exp2f(-dl); l_reg*=f; if(hi==0)wsf[r32]=f; resc=true; } } \
    SBAR(); \
    GAPB(o[0]=__builtin_amdgcn_mfma_f32_32x32x16_bf16(PAF(0),VFR(0),o[0],0,0,0), C0,0); \
    GAPB(o[1]=__builtin_amdgcn_mfma_f32_32x32x16_bf16(PAF(0),VFR(4),o[1],0,0,0), C0,4); \
    KRD(GL,0); GAPB(o[0]=__builtin_amdgcn_mfma_f32_32x32x16_bf16(PAF(1),VFR(1),o[0],0,0,0), C0,8); \
    KRD(GL,1); GAPB(o[1]=__builtin_amdgcn_mfma_f32_32x32x16_bf16(PAF(1),VFR(5),o[1],0,0,0), C0,12); \
    KRD(GL,2); GAPB(o[0]=__builtin_amdgcn_mfma_f32_32x32x16_bf16(PAF(2),VFR(2),o[0],0,0,0), C1,0); \
    KRD(GL,3); GAPB(o[1]=__builtin_amdgcn_mfma_f32_32x32x16_bf16(PAF(2),VFR(6),o[1],0,0,0), C1,4); \
    GAPB(o[0]=__builtin_amdgcn_mfma_f32_32x32x16_bf16(PAF(3),VFR(3),o[0],0,0,0), C1,8); \
    GAPB(o[1]=__builtin_amdgcn_mfma_f32_32x32x16_bf16(PAF(3),VFR(7),o[1],0,0,0), C1,12); \
    }while(0)
  int t=1;
  #undef CMASK
  #define CMASK(P0,P1,t) do{}while(0)
  for(;t+5<NT;t+=2){
    STEP(pB0,pB1,pA0,pA1,t,true,true,true);     WAIT_BAR(2); RESC(); ROT();
    STEP(pA0,pA1,pB0,pB1,t+1,true,true,true);   WAIT_BAR(2); RESC(); ROT();
  }
  #undef CMASK
  #define CMASK(P0,P1,t) do{int jb_=(t)-(NT-4); if(jb_>=0)cmask(P0,P1,jb_,qrel,hi);}while(0)
  #define ENDW(tt) do{ if((tt)+3<NT){WAIT_BAR(2);} else if((tt)+2<NT){WAIT_BAR(1);} else {WAIT_BAR(0);} }while(0)
  for(;t+1<NT;t+=2){
    STEP(pB0,pB1,pA0,pA1,t,(t+3<NT),(t+1<NT),(t+1<NT));       ENDW(t);   RESC(); ROT();
    STEP(pA0,pA1,pB0,pB1,t+1,(t+4<NT),(t+2<NT),(t+2<NT));     ENDW(t+1); RESC(); ROT();
  }
  STEP(pB0,pB1,pA0,pA1,NT-1,false,false,false); RESC();
  { float sacc=pB0[0]+pB0[1]; _Pragma("unroll") for(int r=2;r<16;++r)sacc+=pB0[r]; _Pragma("unroll") for(int r=0;r<16;++r)sacc+=pB1[r]; l_reg+=sacc;
    pw0=(u32x4){PKW(pB0,0),PKW(pB0,2),PKW(pB0,4),PKW(pB0,6)};pw1=(u32x4){PKW(pB0,8),PKW(pB0,10),PKW(pB0,12),PKW(pB0,14)};pw2=(u32x4){PKW(pB1,0),PKW(pB1,2),PKW(pB1,4),PKW(pB1,6)};pw3=(u32x4){PKW(pB1,8),PKW(pB1,10),PKW(pB1,12),PKW(pB1,14)};
    SBAR(); pv(o,vb0+sl_cur,PAF(0),PAF(1),PAF(2),PAF(3)); }
  #undef PKW
  #undef PAF
  #undef VFR
  #undef PIN
  #undef MX3
  #undef GAPA
  #undef GAPB
  #undef EX
  #undef VRD
  #undef KRD
  #undef STEP
  #undef ENDW
  {auto rr=__builtin_amdgcn_permlane32_swap(__float_as_uint(l_reg),__float_as_uint(l_reg),false,false);l_reg=__uint_as_float(rr[0])+__uint_as_float(rr[1]);}
  if(hi==0)wsf[32+r32]=l_reg;asm volatile("s_waitcnt lgkmcnt(0)":::"memory");
  float rli[16];
  #pragma unroll
  for(int r=0;r<16;++r)rli[r]=__builtin_amdgcn_rcpf(wsf[32+crow(r,hi)]);
  bf16*Ow=O+(rowbase+q0+wid*QBLK)*OPITCH+h*D;
  { bf16*stg=(bf16*)(shm+LDS_OST)+wid*2048;
    #pragma unroll
    for(int r=0;r<16;++r){const int orow=crow(r,hi);
      #pragma unroll
      for(int d0=0;d0<2;++d0)stg[orow*64+d0*32+r32]=__float2bfloat16(o[d0][r]*rli[r]);}
    asm volatile("s_waitcnt lgkmcnt(0)":::"memory");
    #pragma unroll
    for(int i=0;i<4;++i){const int row=i*8+(lane>>3),ch=lane&7; const u32x4 v=*(const u32x4*)(stg+row*64+ch*8); ATTN_STORE16(Ow+(long)row*OPITCH+ch*8,v);} }
  asm volatile("s_waitcnt lgkmcnt(0)\n\ts_barrier":::"memory");
  #undef FINIT
  #undef DMA_K
  #undef DMA_V
  #undef CMASK
  #undef START
  #undef RESC
  #undef ROT
}
constexpr int ATTN_LDS_BYTES=LDS_BYTES;
struct AttnTensors { const bf16* Q; const bf16* K; const bf16* V; bf16* O; const float* F2; };
struct AttnUnit { int bh; int qb; };
struct StaticOrder {
  int vcu;
  __device__ __forceinline__ explicit StaticOrder(int grid,int block):vcu((block%8)*(grid/8)+block/8){}
  __device__ __forceinline__ bool next(int i,AttnUnit&u)const{ if(i>=2)return false; const int s=vcu&7; u.bh=vcu>>3; u.qb=(i==0)?15-s:s; return true; }
  __device__ __forceinline__ void a_ready(const AttnUnit&)const{}
  __device__ __forceinline__ void done(const AttnUnit&)const{}
};
template<class Sched,int THRL=8> __device__ __forceinline__ void attn_phase(char*lds,const AttnTensors&T,const Sched&S,const int wid){
  AttnUnit u;
  for(int i=0;S.next(i,u);++i){ S.a_ready(u); attn_unit<THRL>(u.bh/NHEAD,u.bh%NHEAD,u.qb,T.Q,T.K,T.V,T.O,T.F2+(long)u.bh*SEQ,lds,wid); S.done(u); }
}
#undef SBAR
#undef WAIT_BAR
}

struct Args {
    const float* in[21]; float* out; unsigned char* ws; int ph_lo, ph_hi; int use_bar, bar_region;
};
struct Frame {
    LAS unsigned char* lds; volatile LAS unsigned* MISC; unsigned* ctl;
    int wave, vcu, G;
};

__device__ __forceinline__ void tr_item(const float* __restrict__ W, int sld, int scol, int nvalid, int k0, bf16_t* __restrict__ dst, int dld, int drow0, int dcol, LAS float* scr, int lane) {
    const int c = lane & 31;
#pragma unroll 8
    for (int i = 0; i < 32; ++i) { const int kk = 2 * i + (lane >> 5); scr[kk * 33 + c] = (c < nvalid) ? W[(size_t)(k0 + kk) * sld + scol + c] : 0.f; }
    LDS_WAIT(); asm volatile("" ::: "memory");
    const int c8 = lane & 7;
#pragma unroll
    for (int j = 0; j < 4; ++j) { const int n = (lane >> 3) + 8 * j; const LAS float* s = scr + (8 * c8) * 33 + n;
        v4u o; o.x = cvt_pk_bf16(s[0 * 33], s[1 * 33]); o.y = cvt_pk_bf16(s[2 * 33], s[3 * 33]); o.z = cvt_pk_bf16(s[4 * 33], s[5 * 33]); o.w = cvt_pk_bf16(s[6 * 33], s[7 * 33]);
        if (n < nvalid) *(v4u*)(dst + (size_t)(drow0 + n) * dld + dcol + k0 + 8 * c8) = o; }
    LDS_WAIT(); asm volatile("" ::: "memory");
}
__device__ __forceinline__ int gu_row(int n, int which, int g) { return 2 * g * (n / g) + which * g + (n % g); }
__device__ __forceinline__ int rope_row(int n) {
    const int which = n >> 9, c = n & 511, tile = c >> 8, cc = c & 255, hl = cc >> 6, d = cc & 63;
    return which * 512 + tile * 256 + 128 * (d >> 5) + 32 * hl + (d & 31);
}

__device__ __forceinline__ void p0_prologue(const Args& a, Frame& F) {
    unsigned char* ws = a.ws; const int lane_ = lane_id_asm(), tid_ = F.wave * 64 + lane_;
    {
        LAS float* sc = (LAS float*)(F.lds);
        LAS float* part = (LAS float*)(F.lds + 16384);
        float* MOD = (float*)(ws + WS_MOD); const float* c = a.in[1]; const float* w_ada = a.in[2]; const float* b_ada = a.in[3];
        for (int it = blockIdx.x; it < 96; it += F.G) {
            for (int i = tid_; i < 4096; i += 512) { const float cv = c[i]; sc[i] = cv / (1.0f + expf(-cv)); }
            __syncthreads();
            const int col = it * 64 + lane_; float acc0 = 0.f, acc1 = 0.f, acc2 = 0.f, acc3 = 0.f;
            for (int d = F.wave * 128; d < F.wave * 128 + 128; ++d) { const float w = w_ada[(size_t)d * 6144 + col]; acc0 += sc[d] * w; acc1 += sc[1024 + d] * w; acc2 += sc[2048 + d] * w; acc3 += sc[3072 + d] * w; }
            part[(F.wave * 4 + 0) * 64 + lane_] = acc0; part[(F.wave * 4 + 1) * 64 + lane_] = acc1; part[(F.wave * 4 + 2) * 64 + lane_] = acc2; part[(F.wave * 4 + 3) * 64 + lane_] = acc3;
            __syncthreads();
            if (tid_ < 256) { const int b = tid_ >> 6, l = tid_ & 63; float s = 0.f;
#pragma unroll
                for (int w = 0; w < 8; ++w) s += part[(w * 4 + b) * 64 + l];
                MOD[b * 6144 + it * 64 + l] = s + b_ada[it * 64 + l]; }
            __syncthreads();
        }
    }
    { float* COS = (float*)(ws + WS_COS); float* SIN = (float*)(ws + WS_SIN);
      for (int idx = blockIdx.x * 512 + tid_; idx < S_ * 32; idx += F.G * 512) { const int pos = idx >> 5, i = idx & 31;
          const float inv = exp2f(-(float)i * (13.287712379549449f / 32.0f)); const float ang = (float)pos * inv; float s, c; sincos_cw(ang, s, c); COS[idx] = c; SIN[idx] = s; } }
    LAS float* scr = (LAS float*)(F.lds + 32768 + F.wave * 8704);
    bf16_t* WIN = (bf16_t*)(ws + WS_WIN); bf16_t* WAB = (bf16_t*)(ws + WS_WAB); bf16_t* WO = (bf16_t*)(ws + WS_WO); bf16_t* WRS = (bf16_t*)(ws + WS_WRS); bf16_t* WSD = (bf16_t*)(ws + WS_WSD);
    bf16_t* WEG = (bf16_t*)(ws + WS_WEG); bf16_t* WED = (bf16_t*)(ws + WS_WED);
    const float* w_in = a.in[5];
    constexpr int J0 = 16 * 48, J1 = 16 * 32, J2 = 16 * 128, J3 = 16, J4 = 8 * 32, J5 = 16 * 32, J6 = 16 * 32, J7 = 16 * 8, J8 = 16 * 8, J9 = 16 * 8, J10 = 4 * 32;
    constexpr int JS = J0 + J1 + J2 + J3 + J4 + J5 + J6 + J7 + J8 + J9 + J10, JE = 128, NITEMS = JS + 3 * NE * JE;
    const int gw = F.vcu * NWAVES + F.wave, NGW = F.G * NWAVES, lane = lane_;
    for (int it = gw; it < NITEMS; it += NGW) {
        int r = it;
        if (r >= JS) {
            r -= JS; const int e = r / (3 * JE), q = r % (3 * JE), kind = q / JE, j = q % JE;
            if (kind < 2) { const int kb = j >> 3, nb = j & 7; tr_item((kind ? a.in[15] : a.in[14]) + (size_t)e * 1024 * 256, 256, nb * 32, 32, kb * 64, WEG + (size_t)e * 512 * 1024, 1024, gu_row(nb * 32, kind, GU_G_E), 0, scr, lane); }
            else { const int kb = j >> 5, nb = j & 31; tr_item(a.in[16] + (size_t)e * 256 * 1024, 1024, nb * 32, 32, kb * 64, WED + (size_t)e * 1024 * 256, 256, nb * 32, 0, scr, lane); }
            continue;
        }
        if (r < J0) { const int kb = r / 48, nb = r % 48; tr_item(w_in, 6664, nb * 32, 32, kb * 64, WIN, 1024, nb * 32, 0, scr, lane); continue; } r -= J0;
        if (r < J1) { const int kb = r / 32, nb = r % 32; tr_item(w_in, 6664, 1544 + nb * 32, 32, kb * 64, WIN, 1024, 1536 + rope_row(nb * 32), 0, scr, lane); continue; } r -= J1;
        if (r < J2) { const int kb = r / 128, nb = r % 128; tr_item(w_in, 6664, 2568 + nb * 32, 32, kb * 64, WIN, 1024, 2560 + nb * 32, 0, scr, lane); continue; } r -= J2;
        if (r < J3) { tr_item(w_in, 6664, 1536, 8, r * 64, WIN, 1024, 6656, 0, scr, lane); continue; } r -= J3;
        if (r < J4) { const int kb = r / 32, nb = r % 32; tr_item(a.in[8], 1024, nb * 32, 32, kb * 64, WAB, 1536, nb * 32, 0, scr, lane); continue; } r -= J4;
        if (r < J5) { const int kb = r / 32, nb = r % 32; tr_item(a.in[9], 1024, nb * 32, 32, kb * 64, WAB, 1536, nb * 32, 512, scr, lane); continue; } r -= J5;
        if (r < J6) { const int kb = r / 32, nb = r % 32; tr_item(a.in[10], 1024, nb * 32, 32, kb * 64, WO, 1024, nb * 32, 0, scr, lane); continue; } r -= J6;
        if (r < J7) { const int kb = r / 8, nb = r % 8; tr_item(a.in[12], 256, nb * 32, 32, kb * 64, WRS, 1024, nb * 32, 0, scr, lane); continue; } r -= J7;
        if (r < J8) { const int kb = r / 8, nb = r % 8; tr_item(a.in[17], 256, nb * 32, 32, kb * 64, WRS, 1024, 256 + gu_row(nb * 32, 0, GU_G_SH), 0, scr, lane); continue; } r -= J8;
        if (r < J9) { const int kb = r / 8, nb = r % 8; tr_item(a.in[18], 256, nb * 32, 32, kb * 64, WRS, 1024, 256 + gu_row(nb * 32, 1, GU_G_SH), 0, scr, lane); continue; } r -= J9;
        { const int kb = r / 32, nb = r % 32; tr_item(a.in[19], 1024, nb * 32, 32, kb * 64, WSD, 256, nb * 32, 0, scr, lane); }
    }
}

__device__ __forceinline__ void norm_mod_rows(const Frame& F, const float* __restrict__ src, const float* __restrict__ g, const float* __restrict__ mod, int shift_off, int scale_off, bf16_t* __restrict__ dst) {
    const int gw = F.vcu * NWAVES + F.wave, NGW = F.G * NWAVES, lane = lane_id_asm();
    f32x4 gv[4];
#pragma unroll
    for (int j = 0; j < 4; ++j) gv[j] = *((const f32x4*)g + lane + 64 * j);
    for (int row = gw; row < T_; row += NGW) {
        const f32x4* xr = (const f32x4*)(src + (size_t)row * D_) + lane; f32x4 v[4]; float s = 0.f;
#pragma unroll
        for (int j = 0; j < 4; ++j) { v[j] = xr[64 * j]; s += (v[j].x * v[j].x + v[j].y * v[j].y) + (v[j].z * v[j].z + v[j].w * v[j].w); }
        const float r = rsqrtf(wave_sum(s) * (1.f / D_) + EPS);
        const float* mb = mod + (row / S_) * 6144; v2u* o8 = (v2u*)(dst + (size_t)row * D_) + lane;
#pragma unroll
        for (int j = 0; j < 4; ++j) { const f32x4 sc = *((const f32x4*)(mb + scale_off) + lane + 64 * j), sh = *((const f32x4*)(mb + shift_off) + lane + 64 * j);
            const f32x4 y = (v[j] * r) * gv[j] * (sc + 1.0f) + sh; v2u w; w.x = cvt_pk_bf16(y[0], y[1]); w.y = cvt_pk_bf16(y[2], y[3]); o8[64 * j] = w; }
    }
}

__device__ __forceinline__ void cumsum_phase(const Frame& F, const float* __restrict__ LF, float* __restrict__ F2) {
    const int gw = F.vcu * NWAVES + F.wave, lane = lane_id_asm(); if (gw >= 32) return;
    const int b = gw >> 3, h = gw & 7; const float* src = LF + ((size_t)b * S_ + lane * 64) * 8 + h;
    float s = 0.f; for (int i = 0; i < 64; ++i) s += src[i * 8];
    float incl = s;
#pragma unroll
    for (int o = 1; o < 64; o <<= 1) { const float t = __shfl_up(incl, o); if (lane >= o) incl += t; }
    float run = incl - s;
    for (int i = 0; i < 64; ++i) { run += src[i * 8]; F2[(size_t)gw * S_ + lane * 64 + i] = run * LOG2E; }
}

__global__ void __launch_bounds__(NWAVES * 64, 2) mk_fwd(Args args) {
    extern __shared__ __attribute__((aligned(16))) unsigned char lds[];
    Frame F;
    F.lds = (LAS unsigned char*)lds; F.MISC = (volatile LAS unsigned*)(F.lds + MISC_OFF);
    F.wave = __builtin_amdgcn_readfirstlane(threadIdx.x >> 6);
    F.G = gridDim.x; { const int bx = blockIdx.x; F.vcu = (F.G % 8 == 0) ? (bx % 8) * (F.G / 8) + bx / 8 : bx; }
    unsigned char* ws = args.ws; F.ctl = (unsigned*)(ws + WS_CTL);
    for (int u = threadIdx.x; u < (LDS_BYTES - LDSCTL_OFF) / 4; u += NWAVES * 64) ((LAS unsigned*)(F.lds + LDSCTL_OFF))[u] = 0u;
    __syncthreads();
    unsigned* barw = F.ctl + CW_BAR + args.bar_region * XCD_BAR_WORDS;
    XcdBarrier bar; bar.bar = barw; bar.x = 0; bar.st = nullptr;
    if (args.use_bar) bar = xcd_barrier_post(barw, F.MISC + 8);
    const int lo = args.ph_lo, hi = args.ph_hi;
#ifndef PH_OFF
#define PH_OFF 0
#endif
#define IN(k) (!((PH_OFF >> (k)) & 1) && lo <= (k) && (k) < hi)
#define SEAM(k) do { if (IN(k) && IN((k) + 1)) xcd_barrier(bar, F.wave); } while (0)
    float* MOD = (float*)(ws + WS_MOD); bf16_t* XN = (bf16_t*)(ws + WS_XN);

    if (IN(0)) { p0_prologue(args, F); } SEAM(0);
    if (IN(1)) { norm_mod_rows(F, args.in[0], args.in[4], MOD, 0, 1024, XN); } SEAM(1);
    if (IN(2)) {
        pg8::Gemm g{XN, (const bf16_t*)(ws + WS_WIN), T_, NIN, D_, D_, D_}; pg8::StaticOrder S; S.init(T_, NIN, F.G, (int)blockIdx.x);
        pg8::EpiInproj E{(bf16_t*)(ws + WS_QF), (bf16_t*)(ws + WS_KF), (bf16_t*)(ws + WS_VF), (bf16_t*)(ws + WS_RQ), (bf16_t*)(ws + WS_RK), (bf16_t*)(ws + WS_RV), (bf16_t*)(ws + WS_SG),
                         (bf16_t*)(ws + WS_GA), (bf16_t*)(ws + WS_GB), (float*)(ws + WS_LF), (const float*)(ws + WS_COS), (const float*)(ws + WS_SIN), args.in[6]};
        pg8::gemm_phase<pg8::EpiInproj, pg8::StaticOrder, true, true>(F.lds + RING_OFF, g, S, E, F.wave);
    } SEAM(2);
    if (IN(3)) { cumsum_phase(F, (const float*)(ws + WS_LF), (float*)(ws + WS_F2)); } SEAM(3);
    if (IN(4)) {
        static_assert(attn_body::ATTN_LDS_BYTES <= RING_BYTES, "attention LDS");
        const attn_body::AttnTensors AT{(const attn_body::bf16*)(ws + WS_QF), (const attn_body::bf16*)(ws + WS_KF), (const attn_body::bf16*)(ws + WS_VF), (attn_body::bf16*)(ws + WS_AO), (const float*)(ws + WS_F2)};
        const attn_body::StaticOrder S((int)F.G, (int)blockIdx.x);
        attn_body::attn_phase<attn_body::StaticOrder>((char*)lds + RING_OFF, AT, S, F.wave);
    } SEAM(4);
    if (IN(5)) {
        pg8::Gemm g{(const bf16_t*)(ws + WS_AO), (const bf16_t*)(ws + WS_WAB), T_, D_, 1536, 1536, 1536}; pg8::StaticOrder S; S.init(T_, D_, F.G, (int)blockIdx.x);
        pg8::EpiMerge E{(bf16_t*)(ws + WS_MRG), (const bf16_t*)(ws + WS_GA), (const bf16_t*)(ws + WS_GB), 8};
        pg8::gemm_phase<pg8::EpiMerge, pg8::StaticOrder, true, true>(F.lds + RING_OFF, g, S, E, F.wave);
    } SEAM(5);
    if (IN(6)) {
        pg8::Gemm g{(const bf16_t*)(ws + WS_MRG), (const bf16_t*)(ws + WS_WO), T_, D_, D_, D_, D_}; pg8::StaticOrder S; S.init(T_, D_, F.G, (int)blockIdx.x);
        pg8::EpiX1 E{args.in[0], MOD, (float*)(ws + WS_X1)};
        pg8::gemm_phase<pg8::EpiX1, pg8::StaticOrder, true, true>(F.lds + RING_OFF, g, S, E, F.wave);
    } SEAM(6);
    if (IN(7)) { norm_mod_rows(F, (const float*)(ws + WS_X1), args.in[11], MOD, 3072, 4096, XN); } SEAM(7);
    if (IN(8)) {
        pg8::Gemm g{XN, (const bf16_t*)(ws + WS_WRS), T_, 768, D_, D_, D_}; pg8::StaticOrder S; S.init(T_, 768, F.G, (int)blockIdx.x);
        pg8::EpiRS E{(float*)(ws + WS_SCORES), (bf16_t*)(ws + WS_HS)};
        pg8::gemm_phase<pg8::EpiRS, pg8::StaticOrder, true, true>(F.lds + RING_OFF, g, S, E, F.wave);
    } SEAM(8);
    if (IN(9)) {
        pg8::Gemm g{(const bf16_t*)(ws + WS_HS), (const bf16_t*)(ws + WS_WSD), T_, D_, 256, 256, 256}; pg8::StaticOrder S; S.init(T_, D_, F.G, (int)blockIdx.x);
        pg8::EpiPlain<1024> E{(bf16_t*)(ws + WS_MRG)};
        pg8::gemm_phase<pg8::EpiPlain<1024>, pg8::StaticOrder, true, true>(F.lds + RING_OFF, g, S, E, F.wave);
    } SEAM(9);
#undef IN
#undef SEAM
}

__global__ void k_norm_mod(const float* __restrict__ x, const float* __restrict__ g, const float* __restrict__ mod, int shift_off, int scale_off, bf16_t* __restrict__ out) {
    const int row = blockIdx.x * 4 + (threadIdx.x >> 6), lane = threadIdx.x & 63; const int b = row / S_;
    const f32x4* xr = (const f32x4*)(x + (long)row * D_) + lane; f32x4 v[4]; float s = 0.f;
#pragma unroll
    for (int j = 0; j < 4; ++j) { v[j] = xr[64 * j]; s += v[j].x * v[j].x + v[j].y * v[j].y + v[j].z * v[j].z + v[j].w * v[j].w; }
    const float r = rsqrtf(wave_sum(s) * (1.f / D_) + EPS);
    const float* mb = mod + b * 6144;
#pragma unroll
    for (int j = 0; j < 4; ++j) {
        const int c0 = 4 * lane + 256 * j;
#pragma unroll
        for (int e = 0; e < 4; ++e) { const int cc = c0 + e; const float y = v[j][e] * r * g[cc]; out[(long)row * D_ + cc] = f2bf(y * (1.f + mb[scale_off + cc]) + mb[shift_off + cc]); }
    }
}

constexpr int LDS_STR = 40;
template <class ARow, class Epi>
__device__ __forceinline__ void gemm128_tile(const ARow& arow, const bf16_t* __restrict__ Bt, int ldb, int K, const Epi& epi, bf16_t* SA, bf16_t* SB) {
    const int tid = threadIdx.x, wid = tid >> 6, lane = tid & 63, wr = wid >> 1, wc = wid & 1, fr = lane & 15, fq = lane >> 4;
    f32x4 acc[4][4];
#pragma unroll
    for (int m = 0; m < 4; ++m)
#pragma unroll
        for (int n = 0; n < 4; ++n) acc[m][n] = (f32x4){0.f, 0.f, 0.f, 0.f};
    const int r0 = tid >> 2, cb = (tid & 3) * 8;
    const bf16_t* ap0 = arow(r0); const bf16_t* ap1 = arow(r0 + 64);
    const unsigned am0 = arow.ok(r0) ? 0xffffffffu : 0u, am1 = arow.ok(r0 + 64) ? 0xffffffffu : 0u;
    const bf16_t* bp0 = Bt + (long)r0 * ldb + cb; const bf16_t* bp1 = Bt + (long)(r0 + 64) * ldb + cb;
    for (int kt = 0; kt < K / 32; ++kt) {
        uint4 va0 = *(const uint4*)(ap0 + kt * 32 + cb), va1 = *(const uint4*)(ap1 + kt * 32 + cb);
        va0.x &= am0; va0.y &= am0; va0.z &= am0; va0.w &= am0; va1.x &= am1; va1.y &= am1; va1.z &= am1; va1.w &= am1;
        const uint4 vb0 = *(const uint4*)(bp0 + kt * 32), vb1 = *(const uint4*)(bp1 + kt * 32);
        __syncthreads();
        *(uint4*)(SA + r0 * LDS_STR + cb) = va0; *(uint4*)(SA + (r0 + 64) * LDS_STR + cb) = va1;
        *(uint4*)(SB + r0 * LDS_STR + cb) = vb0; *(uint4*)(SB + (r0 + 64) * LDS_STR + cb) = vb1;
        __syncthreads();
        bf16x8 a[4], b[4];
#pragma unroll
        for (int m = 0; m < 4; ++m) a[m] = *(const bf16x8*)(SA + (wr * 64 + m * 16 + fr) * LDS_STR + fq * 8);
#pragma unroll
        for (int n = 0; n < 4; ++n) b[n] = *(const bf16x8*)(SB + (wc * 64 + n * 16 + fr) * LDS_STR + fq * 8);
#pragma unroll
        for (int m = 0; m < 4; ++m)
#pragma unroll
            for (int n = 0; n < 4; ++n) acc[m][n] = __builtin_amdgcn_mfma_f32_16x16x32_bf16(a[m], b[n], acc[m][n], 0, 0, 0);
    }
    epi(acc, wr, wc, fr, fq);
}
struct ARowDense { const bf16_t* A; long lda; __device__ __forceinline__ const bf16_t* operator()(int r) const { return A + (long)r * lda; } __device__ __forceinline__ bool ok(int) const { return true; } };

#define EPI_LOOP_MJ _Pragma("unroll") for (int m = 0; m < 4; ++m) _Pragma("unroll") for (int j = 0; j < 4; ++j)
struct DensePtrs { const bf16_t* A; long lda; const bf16_t* Bt; int ldb; int K; int ntn; int mode; bf16_t* O; const bf16_t* G; float* F; const float* X; const float* mod; bf16_t* O2; };
struct EpiDense {
    DensePtrs p; int row0, gc0;
    __device__ __forceinline__ void operator()(const f32x4 (&acc)[4][4], int wr, int wc, int fr, int fq) const {
        if (p.mode == 3 && gc0 >= 256) {
            EPI_LOOP_MJ { const long row = row0 + wr * 64 + m * 16 + fq * 4 + j;
#pragma unroll
                for (int n = 0; n < 2; ++n) { const int jj = ((gc0 - 256) >> 1) + wc * 32 + n * 16 + fr; p.O2[row * 256 + jj] = f2bf(siluf_(acc[m][n][j]) * acc[m][n + 2][j]); } }
        } else if (p.mode == 3) {
            EPI_LOOP_MJ { const long row = row0 + wr * 64 + m * 16 + fq * 4 + j;
#pragma unroll
                for (int n = 0; n < 4; ++n) p.F[row * 256 + gc0 + wc * 64 + n * 16 + fr] = sigmoidf_(acc[m][n][j]); }
        } else if (p.mode == 0) {
            EPI_LOOP_MJ { const long row = row0 + wr * 64 + m * 16 + fq * 4 + j;
#pragma unroll
                for (int n = 0; n < 4; ++n) { const long o = row * 1024 + gc0 + wc * 64 + n * 16 + fr; p.O[o] = f2bf(acc[m][n][j] * bf2f(p.G[o])); } }
        } else if (p.mode == 1) {
            EPI_LOOP_MJ { const long row = row0 + wr * 64 + m * 16 + fq * 4 + j;
#pragma unroll
                for (int n = 0; n < 4; ++n) { const long o = row * 1024 + gc0 + wc * 64 + n * 16 + fr; p.O[o] = f2bf(bf2f(p.O[o]) + acc[m][n][j] * bf2f(p.G[o])); } }
        } else if (p.mode == 2) {
            EPI_LOOP_MJ { const long row = row0 + wr * 64 + m * 16 + fq * 4 + j; const int b = (int)(row / S_);
#pragma unroll
                for (int n = 0; n < 4; ++n) { const int gcol = gc0 + wc * 64 + n * 16 + fr; const long o = row * 1024 + gcol; p.F[o] = p.X[o] + p.mod[b * 6144 + 2048 + gcol] * acc[m][n][j]; } }
        } else {
            EPI_LOOP_MJ { const long row = row0 + wr * 64 + m * 16 + fq * 4 + j;
#pragma unroll
                for (int n = 0; n < 4; ++n) p.O[row * 1024 + gc0 + wc * 64 + n * 16 + fr] = f2bf(acc[m][n][j]); }
        }
    }
};
__global__ __launch_bounds__(256) void k_gemm_dense(DensePtrs p) {
    __shared__ __attribute__((aligned(16))) bf16_t SA[128 * LDS_STR]; __shared__ __attribute__((aligned(16))) bf16_t SB[128 * LDS_STR];
    const int bn = blockIdx.x % p.ntn, bm = blockIdx.x / p.ntn;
    ARowDense ar{p.A + (long)bm * 128 * p.lda, p.lda}; EpiDense e{p, bm * 128, bn * 128};
    gemm128_tile(ar, p.Bt + (long)bn * 128 * p.ldb, p.ldb, p.K, e, SA, SB);
}

__global__ void k_cumsum(const float* __restrict__ LF, float* __restrict__ F2) {
    const int bh = blockIdx.x, b = bh >> 3, h = bh & 7, lane = threadIdx.x;
    const float* src = LF + ((long)b * S_ + lane * 64) * 8 + h;
    float s = 0.f; for (int i = 0; i < 64; ++i) s += src[i * 8];
    float incl = s;
#pragma unroll
    for (int o = 1; o < 64; o <<= 1) { const float t = __shfl_up(incl, o); if (lane >= o) incl += t; }
    float run = incl - s;
    for (int i = 0; i < 64; ++i) { run += src[i * 8]; F2[(long)bh * S_ + lane * 64 + i] = run * LOG2E; }
}

__global__ __launch_bounds__(256) void k_fox_naive(const bf16_t* __restrict__ QF, const bf16_t* __restrict__ KF, const bf16_t* __restrict__ VF, const float* __restrict__ F2, bf16_t* __restrict__ AO) {
    const int gw = blockIdx.x * 4 + (threadIdx.x >> 6), lane = threadIdx.x & 63;
    const int t = gw >> 3, h = gw & 7, b = t / S_, tq = t % S_, bh = b * 8 + h;
    float q[64];
    { const bf16_t* qp = QF + (long)t * 512 + h * 64;
#pragma unroll
      for (int d = 0; d < 64; ++d) q[d] = bf2f(qp[d]); }
    const float fq2 = F2[(long)bh * S_ + tq];
    float o[64];
#pragma unroll
    for (int d = 0; d < 64; ++d) o[d] = 0.f;
    float m = -INFINITY, l = 0.f;
    for (int k = lane; k <= tq; k += 64) {
        const long kr = (long)(b * S_ + k) * 512 + h * 64;
        float s = 0.f;
#pragma unroll
        for (int c = 0; c < 8; ++c) { const uint4 u = *(const uint4*)(KF + kr + c * 8); const unsigned w[4] = {u.x, u.y, u.z, u.w};
#pragma unroll
            for (int e = 0; e < 4; ++e) { s += q[c * 8 + 2 * e] * __uint_as_float(w[e] << 16); s += q[c * 8 + 2 * e + 1] * __uint_as_float(w[e] & 0xffff0000u); } }
        s += fq2 - F2[(long)bh * S_ + k];
        if (s > m) { const float f = exp2f(m - s); l *= f;
#pragma unroll
            for (int d = 0; d < 64; ++d) o[d] *= f;
            m = s; }
        const float p = exp2f(s - m); l += p;
#pragma unroll
        for (int c = 0; c < 8; ++c) { const uint4 u = *(const uint4*)(VF + kr + c * 8); const unsigned w[4] = {u.x, u.y, u.z, u.w};
#pragma unroll
            for (int e = 0; e < 4; ++e) { o[c * 8 + 2 * e] += p * __uint_as_float(w[e] << 16); o[c * 8 + 2 * e + 1] += p * __uint_as_float(w[e] & 0xffff0000u); } }
    }
    float M = m;
#pragma unroll
    for (int off = 1; off < 64; off <<= 1) M = fmaxf(M, __shfl_xor(M, off));
    const float f = (m == -INFINITY) ? 0.f : exp2f(m - M);
    const float lt = wave_sum(l * f); float mine = 0.f;
#pragma unroll
    for (int d = 0; d < 64; ++d) { const float v = wave_sum(o[d] * f); if (lane == d) mine = v; }
    AO[(long)t * 1536 + h * 64 + lane] = f2bf(mine / lt);
}

__device__ __forceinline__ float ret_loggamma(int h) { return log1pf(-exp2f(-5.0f - (float)h)); }
__global__ __launch_bounds__(256) void k_ret_kv(const bf16_t* __restrict__ RK, const bf16_t* __restrict__ RV, float* __restrict__ KVN) {
    __shared__ bf16_t sk[128 * 64]; __shared__ bf16_t sv[128 * 128];
    const int bh = blockIdx.x >> 5, n = blockIdx.x & 31, b = bh >> 3, h = bh & 7, tid = threadIdx.x;
    const long t0 = (long)b * S_ + n * 128;
    for (int i = tid; i < 128 * 64; i += 256) sk[i] = RK[(t0 + (i >> 6)) * 512 + h * 64 + (i & 63)];
    for (int i = tid; i < 128 * 128; i += 256) sv[i] = RV[(t0 + (i >> 7)) * 1024 + h * 128 + (i & 127)];
    __syncthreads();
    const int d = tid >> 2, e0 = (tid & 3) * 32; const float lg = ret_loggamma(h);
    float acc[32];
#pragma unroll
    for (int e = 0; e < 32; ++e) acc[e] = 0.f;
    for (int j = 0; j < 128; ++j) { const float kz = bf2f(sk[j * 64 + d]) * expf((127.f - (float)j) * lg);
#pragma unroll
        for (int e = 0; e < 32; ++e) acc[e] += kz * bf2f(sv[j * 128 + e0 + e]); }
    float* dst = KVN + (((long)bh * 32 + n) * 64 + d) * 128 + e0;
#pragma unroll
    for (int e = 0; e < 32; ++e) dst[e] = acc[e];
}
__global__ void k_ret_scan(float* __restrict__ KVN) {
    const int idx = blockIdx.x * blockDim.x + threadIdx.x; const int bh = idx >> 13, r = idx & 8191, h = bh & 7;
    const float cd = expf(128.f * ret_loggamma(h)); float st = 0.f;
    for (int n = 0; n < 32; ++n) { float* p = KVN + ((long)bh * 32 + n) * 8192 + r; const float tmp = *p; *p = st; st = cd * st + tmp; }
}
__global__ __launch_bounds__(256) void k_ret_out(const bf16_t* __restrict__ RQ, const bf16_t* __restrict__ RK, const bf16_t* __restrict__ RV, const float* __restrict__ PREV,
                                                 const float* __restrict__ gn_g, const bf16_t* __restrict__ SG, bf16_t* __restrict__ AO) {
    __shared__ bf16_t sk[128 * 64]; __shared__ bf16_t sv[128 * 128];
    const int bh = blockIdx.x >> 5, n = blockIdx.x & 31, b = bh >> 3, h = bh & 7, tid = threadIdx.x, i = tid >> 1, e0 = (tid & 1) * 64;
    const long t0 = (long)b * S_ + n * 128;
    for (int x = tid; x < 128 * 64; x += 256) sk[x] = RK[(t0 + (x >> 6)) * 512 + h * 64 + (x & 63)];
    for (int x = tid; x < 128 * 128; x += 256) sv[x] = RV[(t0 + (x >> 7)) * 1024 + h * 128 + (x & 127)];
    __syncthreads();
    const float lg = ret_loggamma(h); const long t = t0 + i;
    float acc[64];
#pragma unroll
    for (int e = 0; e < 64; ++e) acc[e] = 0.f;
    const bf16_t* qp = RQ + t * 512 + h * 64;
    for (int j = 0; j <= i; ++j) {
        float s = 0.f;
#pragma unroll 16
        for (int d = 0; d < 64; ++d) s += bf2f(qp[d]) * bf2f(sk[j * 64 + d]);
        s *= expf((float)(i - j) * lg);
#pragma unroll
        for (int e = 0; e < 64; ++e) acc[e] += s * bf2f(sv[j * 128 + e0 + e]);
    }
    const float xi = expf((float)(i + 1) * lg); const float* pv = PREV + ((long)bh * 32 + n) * 8192 + e0;
    for (int d = 0; d < 64; ++d) { const float qd = bf2f(qp[d]) * xi;
#pragma unroll
        for (int e = 0; e < 64; ++e) acc[e] += qd * pv[d * 128 + e]; }
    float mu = 0.f;
#pragma unroll
    for (int e = 0; e < 64; ++e) mu += acc[e];
    mu += __shfl_xor(mu, 1); mu *= (1.f / 128.f); float var = 0.f;
#pragma unroll
    for (int e = 0; e < 64; ++e) { const float dd = acc[e] - mu; var += dd * dd; }
    var += __shfl_xor(var, 1);
    const float rs = rsqrtf(var * (1.f / 128.f) + EPS);
#pragma unroll
    for (int e = 0; e < 64; ++e) { const float y = (acc[e] - mu) * rs * gn_g[h * 128 + e0 + e]; AO[t * 1536 + 512 + h * 128 + e0 + e] = f2bf(y * bf2f(SG[t * 1024 + h * 128 + e0 + e])); }
}

__global__ __launch_bounds__(256) void k_route(const float* __restrict__ SC, const float* __restrict__ rbias, unsigned* __restrict__ CNT, int* __restrict__ LTOK, float* __restrict__ LW) {
    const int t = blockIdx.x * 4 + (threadIdx.x >> 6), lane = threadIdx.x & 63;
    const f32x4 sc = *((const f32x4*)(SC + (long)t * 256) + lane); const f32x4 rb = *((const f32x4*)rbias + lane);
    float sel[4];
#pragma unroll
    for (int i = 0; i < 4; ++i) sel[i] = sc[i] + rb[i];
    float a1 = fmaxf(sel[0], sel[1]), a2 = fminf(sel[0], sel[1]);
    { const float b1 = fmaxf(sel[2], sel[3]), b2 = fminf(sel[2], sel[3]); const float n1 = fmaxf(a1, b1), n2 = fmaxf(fminf(a1, b1), fmaxf(a2, b2)); a1 = n1; a2 = n2; }
#pragma unroll
    for (int o = 1; o < 8; o <<= 1) { const float b1 = __shfl_xor(a1, o), b2 = __shfl_xor(a2, o); const float n1 = fmaxf(a1, b1), n2 = fmaxf(fminf(a1, b1), fmaxf(a2, b2)); a1 = n1; a2 = n2; }
    const float gs = a1 + a2; const int g = lane >> 3; int rank = 0;
#pragma unroll
    for (int gg = 0; gg < 8; ++gg) { const float o = __shfl(gs, gg * 8); rank += (o > gs || (o == gs && gg < g)) ? 1 : 0; }
    const bool allowed = rank < 4;
    float cand[4];
#pragma unroll
    for (int i = 0; i < 4; ++i) cand[i] = allowed ? sel[i] : -INFINITY;
    int myE = 0; float mySc = 0.f;
    for (int r = 0; r < TOPK; ++r) {
        float bv = cand[0]; int bi = lane * 4; float bs = sc[0];
#pragma unroll
        for (int i = 1; i < 4; ++i) if (cand[i] > bv) { bv = cand[i]; bi = lane * 4 + i; bs = sc[i]; }
#pragma unroll
        for (int o = 1; o < 64; o <<= 1) { const float ov = __shfl_xor(bv, o); const int oi = __shfl_xor(bi, o); const float os = __shfl_xor(bs, o);
            if (ov > bv || (ov == bv && oi < bi)) { bv = ov; bi = oi; bs = os; } }
        if ((bi >> 2) == lane) {
#pragma unroll
            for (int i = 0; i < 4; ++i) if ((bi & 3) == i) cand[i] = -INFINITY;
        }
        if (lane == r) { myE = bi; mySc = bs; }
    }
    float tot = (lane < TOPK) ? mySc : 0.f;
#pragma unroll
    for (int o = 1; o < 8; o <<= 1) tot += __shfl_xor(tot, o);
    if (lane < TOPK) { const float w = mySc / tot * 2.5f; const unsigned slot = atomicAdd(&CNT[myE], 1u); LTOK[(long)myE * CAP + slot] = t * 8 + lane; LW[(long)myE * CAP + slot] = w; }
}
__global__ void k_blocktable(const unsigned* __restrict__ CNT, int* __restrict__ BLK) {
    __shared__ int start[257];
    if (threadIdx.x == 0) { int s = 0; for (int e = 0; e < NE; ++e) { start[e] = s; s += ((int)CNT[e] + 127) >> 7; } start[256] = s; BLK[2048 + 256] = s; }
    __syncthreads();
    const int e = threadIdx.x; BLK[2048 + e] = start[e] * 128;
    for (int b = start[e]; b < start[e + 1]; ++b) BLK[b] = e;
}

struct MoePtrs { const bf16_t* H2; const bf16_t* WEG; const bf16_t* WED; const unsigned* CNT; const int* BLK; const int* LTOK; const float* LW; bf16_t* HE; bf16_t* YS; };
struct ARowGather { const bf16_t* H2; const int* ltok; int valid; __device__ __forceinline__ const bf16_t* operator()(int r) const { return H2 + (long)((r < valid ? ltok[r] : 0) >> 3) * D_; } __device__ __forceinline__ bool ok(int r) const { return r < valid; } };
struct EpiMoeUp {
    bf16_t* HE; long hrow0; int ct;
    __device__ __forceinline__ void operator()(const f32x4 (&acc)[4][4], int wr, int wc, int fr, int fq) const {
#pragma unroll
        for (int m = 0; m < 4; ++m)
#pragma unroll
            for (int j = 0; j < 4; ++j) { const long row = hrow0 + wr * 64 + m * 16 + fq * 4 + j;
#pragma unroll
                for (int n = 0; n < 2; ++n) HE[row * 256 + ct * 64 + wc * 32 + n * 16 + fr] = f2bf(siluf_(acc[m][n][j]) * acc[m][n + 2][j]); }
    }
};
__global__ __launch_bounds__(256) void k_moe_up(MoePtrs p) {
    __shared__ __attribute__((aligned(16))) bf16_t SA[128 * LDS_STR]; __shared__ __attribute__((aligned(16))) bf16_t SB[128 * LDS_STR];
    const int blk = blockIdx.x >> 2, ct = blockIdx.x & 3; if (blk >= p.BLK[2048 + 256]) return;
    const int e = p.BLK[blk], pst = p.BLK[2048 + e], s0 = blk * 128 - pst; int valid = (int)p.CNT[e] - s0; valid = valid > 128 ? 128 : valid;
    ARowGather ar{p.H2, p.LTOK + (long)e * CAP + s0, valid}; EpiMoeUp ep{p.HE, (long)pst + s0, ct};
    gemm128_tile(ar, p.WEG + ((long)e * 512 + ct * 128) * D_, D_, D_, ep, SA, SB);
}
struct EpiMoeDown {
    bf16_t* YS; const int* ltok; const float* lw; int valid, gc0;
    __device__ __forceinline__ void operator()(const f32x4 (&acc)[4][4], int wr, int wc, int fr, int fq) const {
#pragma unroll
        for (int m = 0; m < 4; ++m)
#pragma unroll
            for (int j = 0; j < 4; ++j) { const int r = wr * 64 + m * 16 + fq * 4 + j; if (r < valid) { const long dst = (long)ltok[r] * D_; const float w = lw[r];
#pragma unroll
                for (int n = 0; n < 4; ++n) YS[dst + gc0 + wc * 64 + n * 16 + fr] = f2bf(acc[m][n][j] * w); } }
    }
};
__global__ __launch_bounds__(256) void k_moe_down(MoePtrs p) {
    __shared__ __attribute__((aligned(16))) bf16_t SA[128 * LDS_STR]; __shared__ __attribute__((aligned(16))) bf16_t SB[128 * LDS_STR];
    const int blk = blockIdx.x >> 3, ct = blockIdx.x & 7; if (blk >= p.BLK[2048 + 256]) return;
    const int e = p.BLK[blk], pst = p.BLK[2048 + e], s0 = blk * 128 - pst; int valid = (int)p.CNT[e] - s0; valid = valid > 128 ? 128 : valid;
    ARowDense ar{p.HE + (long)(pst + s0) * 256, 256}; EpiMoeDown ep{p.YS, p.LTOK + (long)e * CAP + s0, p.LW + (long)e * CAP + s0, valid, ct * 128};
    gemm128_tile(ar, p.WED + ((long)e * 1024 + ct * 128) * 256, 256, 256, ep, SA, SB);
}

__global__ void k_final(const float* __restrict__ X1, const bf16_t* __restrict__ YS, const bf16_t* __restrict__ SHO, const float* __restrict__ mod, const float* __restrict__ fg, float* __restrict__ out) {
    const int row = blockIdx.x * 4 + (threadIdx.x >> 6), lane = threadIdx.x & 63; const int b = row / S_;
    float v[16]; float s = 0.f;
#pragma unroll
    for (int j = 0; j < 4; ++j)
#pragma unroll
        for (int e = 0; e < 4; ++e) {
            const int cc = 4 * lane + 256 * j + e; float r = bf2f(SHO[(long)row * D_ + cc]);
#pragma unroll
            for (int k = 0; k < 8; ++k) r += bf2f(YS[((long)row * 8 + k) * D_ + cc]);
            const float y = X1[(long)row * D_ + cc] + mod[b * 6144 + 5120 + cc] * r; v[j * 4 + e] = y; s += y * y;
        }
    const float rr = rsqrtf(wave_sum(s) * (1.f / D_) + EPS);
#pragma unroll
    for (int j = 0; j < 4; ++j)
#pragma unroll
        for (int e = 0; e < 4; ++e) { const int cc = 4 * lane + 256 * j + e; out[(long)row * D_ + cc] = v[j * 4 + e] * rr * fg[cc]; }
}


extern "C" void kernel_launch(void* const* d_in, const int* in_sizes, int n_in, void* d_out, int out_size, void* d_ws, size_t ws_size, hipStream_t stream) {
    static int grid = 0;
    if (grid == 0) {
        if (n_in != 21 || ws_size < WS_END || out_size != T_ * D_) { fprintf(stderr, "kernel_launch: unexpected n_in %d / ws %zu / out %d\n", n_in, ws_size, out_size); grid = -1; return; }
        int dev = 0, cus = 0, per_cu = 0;
        (void)hipGetDevice(&dev); (void)hipDeviceGetAttribute(&cus, hipDeviceAttributeMultiprocessorCount, dev);
        if (hipFuncSetAttribute((const void*)mk_fwd, hipFuncAttributeMaxDynamicSharedMemorySize, LDS_BYTES) != hipSuccess) { fprintf(stderr, "kernel_launch: hipFuncSetAttribute failed\n"); grid = -1; return; }
        if (hipOccupancyMaxActiveBlocksPerMultiprocessor(&per_cu, (const void*)mk_fwd, NWAVES * 64, LDS_BYTES) != hipSuccess || per_cu < 1) { fprintf(stderr, "kernel_launch: occupancy query says %d\n", per_cu); per_cu = 1; }
        (void)hipGetLastError();
        grid = cus;
        if (grid != 256) fprintf(stderr, "kernel_launch: note: %d CUs\n", grid);
    }
    if (grid < 0) return;
    const float* x = (const float*)d_in[0]; const float* ret_gn_g = (const float*)d_in[7]; const float* norm2_g = (const float*)d_in[11];
    const float* router_bias = (const float*)d_in[13]; const float* final_g = (const float*)d_in[20];
    char* ws = (char*)d_ws; float* out = (float*)d_out;
    unsigned* CNT = (unsigned*)(ws + WS_CTL); float* MOD = (float*)(ws + WS_MOD);
    float* F2 = (float*)(ws + WS_F2); float* LF = (float*)(ws + WS_LF); int* BLK = (int*)(ws + WS_BLK);
    bf16_t* WIN = (bf16_t*)(ws + WS_WIN); bf16_t* WAB = (bf16_t*)(ws + WS_WAB); bf16_t* WO = (bf16_t*)(ws + WS_WO); bf16_t* WRS = (bf16_t*)(ws + WS_WRS); bf16_t* WSD = (bf16_t*)(ws + WS_WSD);
    bf16_t* WEG = (bf16_t*)(ws + WS_WEG); bf16_t* WED = (bf16_t*)(ws + WS_WED); bf16_t* XN = (bf16_t*)(ws + WS_XN);
    bf16_t* QF = (bf16_t*)(ws + WS_QF); bf16_t* KF = (bf16_t*)(ws + WS_KF); bf16_t* VF = (bf16_t*)(ws + WS_VF); bf16_t* RQ = (bf16_t*)(ws + WS_RQ); bf16_t* RK = (bf16_t*)(ws + WS_RK);
    bf16_t* RV = (bf16_t*)(ws + WS_RV); bf16_t* SG = (bf16_t*)(ws + WS_SG); bf16_t* GA = (bf16_t*)(ws + WS_GA); bf16_t* GB = (bf16_t*)(ws + WS_GB);
    bf16_t* AO = (bf16_t*)(ws + WS_AO); bf16_t* MRG = (bf16_t*)(ws + WS_MRG); float* X1 = (float*)(ws + WS_X1); float* KVN = (float*)(ws + WS_KVN);
    float* SCORES = (float*)(ws + WS_SCORES); bf16_t* HS = (bf16_t*)(ws + WS_HS); int* LTOK = (int*)(ws + WS_LTOK); float* LW = (float*)(ws + WS_LW);
    bf16_t* HE = (bf16_t*)(ws + WS_HE); bf16_t* YS = (bf16_t*)(ws + WS_YS);

    (void)hipMemsetAsync(ws + WS_CTL, 0, 1 * MiB, stream);
    (void)hipMemsetAsync(WIN + (size_t)6664 * D_, 0, (size_t)(NIN - 6664) * D_ * 2, stream);
    Args a{};
    for (int i = 0; i < 21; ++i) a.in[i] = (const float*)d_in[i];
    a.out = out; a.ws = (unsigned char*)d_ws; a.ph_lo = 0; a.ph_hi = 5; a.use_bar = 1; a.bar_region = 0;
    void* kargs[] = {&a};
    hipError_t le = hipLaunchCooperativeKernel((const void*)mk_fwd, dim3(grid), dim3(NWAVES * 64), kargs, LDS_BYTES, stream);
    if (le != hipSuccess) fprintf(stderr, "kernel_launch: cooperative launch failed: %s\n", hipGetErrorString(le));
    k_ret_kv<<<1024, 256, 0, stream>>>(RK, RV, KVN);
    k_ret_scan<<<32 * 8192 / 256, 256, 0, stream>>>(KVN);
    k_ret_out<<<1024, 256, 0, stream>>>(RQ, RK, RV, KVN, ret_gn_g, SG, AO);
    Args a2 = a; a2.ph_lo = 5; a2.ph_hi = 10; a2.bar_region = 1;
    void* kargs2[] = {&a2};
    le = hipLaunchCooperativeKernel((const void*)mk_fwd, dim3(grid), dim3(NWAVES * 64), kargs2, LDS_BYTES, stream);
    if (le != hipSuccess) fprintf(stderr, "kernel_launch: cooperative launch 2 failed: %s\n", hipGetErrorString(le));
    k_route<<<T_ / 4, 256, 0, stream>>>(SCORES, router_bias, CNT, LTOK, LW);
    k_blocktable<<<1, 256, 0, stream>>>(CNT, BLK);
    MoePtrs mp{XN, WEG, WED, CNT, BLK, LTOK, LW, HE, YS};
    k_moe_up<<<1280 * 4, 256, 0, stream>>>(mp);
    k_moe_down<<<1280 * 8, 256, 0, stream>>>(mp);
    k_final<<<T_ / 4, 256, 0, stream>>>(X1, YS, MRG, MOD, final_g, out);
}
```

```cpp
#include <hip/hip_runtime.h>
#include <stdint.h>
#include <cstdio>

typedef unsigned short bf16_t;
typedef short bf16x8 __attribute__((ext_vector_type(8)));
typedef float f32x4 __attribute__((ext_vector_type(4)));

constexpr int T_ = 16384, D_ = 1024, S_ = 4096, NBATCH = 4;
constexpr int NIN = 6912;
constexpr int NE = 256, CAP = 16384, TOPK = 8;
constexpr float EPS = 1e-6f;
constexpr float LOG2E = 1.4426950408889634f;
constexpr float C2 = 0.125f * LOG2E;

constexpr size_t MiB = 1u << 20;
constexpr size_t WS_CTL = 0;
constexpr size_t WS_MOD = 1 * MiB;
constexpr size_t WS_COS = 1 * MiB + 256 * 1024;
constexpr size_t WS_SIN = WS_COS + 512 * 1024;
constexpr size_t WS_F2 = 2 * MiB + 512 * 1024;
constexpr size_t WS_LF = 3 * MiB;
constexpr size_t WS_BLK = 3 * MiB + 512 * 1024;
constexpr size_t WS_WIN = 8 * MiB;
constexpr size_t WS_WAB = 22 * MiB;
constexpr size_t WS_WO = 25 * MiB;
constexpr size_t WS_WRS = 27 * MiB;
constexpr size_t WS_WSD = 28 * MiB + 512 * 1024;
constexpr size_t WS_WEG = 32 * MiB;
constexpr size_t WS_WED = 288 * MiB;
constexpr size_t WS_XN = 416 * MiB;
constexpr size_t WS_QF = 448 * MiB, WS_KF = 464 * MiB, WS_VF = 480 * MiB, WS_RQ = 496 * MiB, WS_RK = 512 * MiB;
constexpr size_t WS_RV = 528 * MiB, WS_SG = 560 * MiB, WS_GA = 592 * MiB, WS_GB = 624 * MiB;
constexpr size_t WS_AO = 656 * MiB;
constexpr size_t WS_MRG = 704 * MiB;
constexpr size_t WS_X1 = 736 * MiB;
constexpr size_t WS_KVN = 800 * MiB;
constexpr size_t WS_SCORES = 832 * MiB;
constexpr size_t WS_HS = 848 * MiB;
constexpr size_t WS_LTOK = 860 * MiB;
constexpr size_t WS_LW = 876 * MiB;
constexpr size_t WS_HE = 892 * MiB;
constexpr size_t WS_YS = 448 * MiB;
constexpr size_t WS_END = 988 * MiB;

__device__ __forceinline__ float bf2f(bf16_t v) { return __uint_as_float(((unsigned)v) << 16); }
__device__ __forceinline__ bf16_t f2bf(float f) { unsigned u = __float_as_uint(f); return (bf16_t)((u + 0x7fffu + ((u >> 16) & 1u)) >> 16); }
__device__ __forceinline__ float sigmoidf_(float x) { return 1.0f / (1.0f + __expf(-x)); }
__device__ __forceinline__ float siluf_(float x) { return x / (1.0f + __expf(-x)); }
__device__ __forceinline__ float logsigmoidf_(float x) { return x >= 0.f ? -log1pf(expf(-x)) : x - log1pf(expf(x)); }
__device__ __forceinline__ float wave_sum(float v) {
#pragma unroll
    for (int o = 1; o < 64; o <<= 1) v += __shfl_xor(v, o);
    return v;
}

__device__ __forceinline__ void sincos_cw(float x, float& s, float& c) {
    int j = (int)(x * 1.27323954473516f); float y = (float)j; if (j & 1) { ++j; y += 1.f; }
    j &= 7; float ss = 1.f, cs = 1.f; if (j > 3) { ss = -1.f; cs = -1.f; j -= 4; } if (j > 1) cs = -cs;
    x = ((x - y * 0.78515625f) - y * 2.4187564849853515625e-4f) - y * 3.77489497744594108e-8f;
    const float z = x * x;
    const float ps = ((-1.9515295891e-4f * z + 8.3321608736e-3f) * z - 1.6666654611e-1f) * z * x + x;
    const float pc = ((2.443315711809948e-5f * z - 1.388731625493765e-3f) * z + 4.166664568298827e-2f) * z * z - 0.5f * z + 1.0f;
    if (j == 2) { s = ss * pc; c = cs * ps; } else { s = ss * ps; c = cs * pc; }
}
#define GAS __attribute__((address_space(1)))
#define LAS __attribute__((address_space(3)))
typedef unsigned v4u __attribute__((ext_vector_type(4)));
typedef unsigned v2u __attribute__((ext_vector_type(2)));
#define LDS_WAIT() asm volatile("s_waitcnt lgkmcnt(0)" ::: "memory")
#define VM_WAIT() asm volatile("s_waitcnt vmcnt(0)" ::: "memory")
typedef float f32x2_t __attribute__((ext_vector_type(2))); typedef __bf16 bf16x2_t __attribute__((ext_vector_type(2)));
__device__ __forceinline__ unsigned cvt_pk_bf16(float lo, float hi) { f32x2_t v = {lo, hi}; bf16x2_t b = __builtin_convertvector(v, bf16x2_t); return __builtin_bit_cast(unsigned, b); }
__device__ __forceinline__ float fast_sigmoid(float x) { return __builtin_amdgcn_rcpf(1.0f + __builtin_amdgcn_exp2f(-LOG2E * x)); }
__device__ __forceinline__ float fast_silu(float x) { return x * fast_sigmoid(x); }

__device__ __forceinline__ int lane_id_asm() { int l; asm volatile("v_mbcnt_lo_u32_b32 %0, -1, 0\n\tv_mbcnt_hi_u32_b32 %0, -1, %0" : "=v"(l)); return l; }
constexpr int NWAVES = 8;
constexpr int RING_OFF = 0, RING_BYTES = 131072;
constexpr int LDSCTL_OFF = RING_BYTES, MISC_OFF = LDSCTL_OFF + 320;
constexpr int LDS_BYTES = 147456;
constexpr int CW_BAR = 4096;
constexpr int GU_G_SH = 128;
constexpr int GU_G_E = 128;

namespace pg8 {
#define PG8_LAS __attribute__((address_space(3)))
typedef unsigned short bf16_t;
typedef short bf16x8 __attribute__((ext_vector_type(8)));
typedef float f32x4 __attribute__((ext_vector_type(4)));
typedef unsigned u32x4 __attribute__((ext_vector_type(4)));
constexpr int BM = 256, BK = 64, HALF = 128, HTB = HALF * BK * 2  , STAGE_BYTES = 8 * HTB, NXCD = 8, WGM = 8;

__host__ __device__ __forceinline__ int lds_byte(int r, int c) { const int st = (r >> 4) * 2 + (c >> 5), rr = r & 15, cc = c & 31, ob = rr * 64 + cc * 2; return st * 1024 + (ob ^ (((ob >> 9) & 1) << 5)); }
__host__ __device__ __forceinline__ void stage_rc(int b, int& R, int& C) { const int st = b / 1024, sb = b % 1024, swz = sb ^ (((sb >> 9) & 1) << 5); R = (st >> 1) * 16 + swz / 64; C = (st & 1) * 32 + (swz % 64) / 2; }
__host__ __device__ __forceinline__ int perm32(int rho) { const int n = rho >> 4, i = rho & 15; return 8 * (i >> 2) + 4 * n + (i & 3); }

struct Unit { int pm, pn; };
struct Gemm { const bf16_t* A; const bf16_t* Bt; int M, N, K, lda, ldb; };

struct StaticOrder {
    int nM, nN, nwg, G, c;
    __host__ __device__ void init(int M, int N, int G_, int c_) { nM = M / BM; nN = N / BM; nwg = nM * nN; G = G_; c = c_; }
    __host__ __device__ bool next(int i, Unit& u) const {
        const long L = (long)i * G + c; if (L >= nwg) return false;
        int wgid = (int)L; { const int q = nwg / NXCD, r = nwg % NXCD, xcd = wgid % NXCD, off = wgid / NXCD; wgid = (xcd < r ? xcd * (q + 1) : r * (q + 1) + (xcd - r) * q) + off; }
        const int nig = WGM * nN, gid = wgid / nig, fm = gid * WGM, gsz = (nM - fm) < WGM ? (nM - fm) : WGM;
        u.pm = fm + ((wgid % nig) % gsz); u.pn = (wgid % nig) / gsz; return true;
    }
    __device__ __forceinline__ void a_ready(const Unit&) const {}
    __device__ __forceinline__ void done(const Unit&) const {}
};

#define PG8_FOR_AI_M _Pragma("unroll") for (int ai = 0; ai < 2; ++ai) _Pragma("unroll") for (int m = 0; m < 4; ++m)
__device__ __forceinline__ u32x4 pack8(const f32x4& v0, const f32x4& v1) { u32x4 w; w.x = cvt_pk_bf16(v0[0], v0[1]); w.y = cvt_pk_bf16(v0[2], v0[3]); w.z = cvt_pk_bf16(v1[0], v1[1]); w.w = cvt_pk_bf16(v1[2], v1[3]); return w; }
template <int ACT> __device__ __forceinline__ f32x4 act4(f32x4 v, float sc) {
    if (ACT == 1) { v = v * sc; }
    else if (ACT == 2) { v[0] = fast_silu(v[0]); v[1] = fast_silu(v[1]); v[2] = fast_silu(v[2]); v[3] = fast_silu(v[3]); }
    else if (ACT == 3) { v[0] = fast_sigmoid(v[0]); v[1] = fast_sigmoid(v[1]); v[2] = fast_sigmoid(v[2]); v[3] = fast_sigmoid(v[3]); }
    return v;
}
struct EpiInproj {
    static constexpr bool PERM = true, AFTER_DRAIN = false, HAS_MID = false;
    bf16_t *QF, *KF, *VF, *RQ, *RK, *RV, *SG, *GA, *GB; float* LF; const float *COS, *SIN, *bforget;
    template <int ACT> __device__ __forceinline__ void plain(const f32x4 (&acc)[2][2][4][2], bf16_t* O, int ldc, int colt, float sc, int row0, int col8) const {
        PG8_FOR_AI_M { bf16_t* rowp = O + (size_t)(row0 + ai * HALF + m * 16) * ldc + colt + col8;
#pragma unroll
            for (int bj = 0; bj < 2; ++bj) *(u32x4*)(rowp + bj * HALF) = pack8(act4<ACT>(acc[ai][bj][m][0], sc), act4<ACT>(acc[ai][bj][m][1], sc)); }
    }
    __device__ __forceinline__ void operator()(const f32x4 (&acc)[2][2][4][2], const Unit& u, int wr, int wc, int fr, int fq) const {
        const int pn = u.pn, row0 = u.pm * BM + wr * 64 + fr, col8 = wc * 32 + 8 * fq;
        if (pn < 2) plain<1>(acc, QF, 512, pn * 256, C2, row0, col8);
        else if (pn < 4) plain<0>(acc, KF, 512, (pn - 2) * 256, 1.f, row0, col8);
        else if (pn < 6) plain<0>(acc, VF, 512, (pn - 4) * 256, 1.f, row0, col8);
        else if (pn < 10) {
            const bool isq = pn < 8; bf16_t* O = isq ? RQ : RK; const float sc = isq ? 1.f : 0.125f; const int hc = (4 * (pn & 1) + wc) * 64 + 8 * fq;
            PG8_FOR_AI_M { const int row = row0 + ai * HALF + m * 16, pos = row & (S_ - 1);
                f32x4 o1[2], o2[2];
#pragma unroll
                for (int n = 0; n < 2; ++n) { const f32x4 cs = *(const f32x4*)(COS + pos * 32 + 8 * fq + 4 * n), sn = *(const f32x4*)(SIN + pos * 32 + 8 * fq + 4 * n);
                    const f32x4 x1 = acc[ai][0][m][n], x2 = acc[ai][1][m][n]; o1[n] = (x1 * cs - x2 * sn) * sc; o2[n] = (x1 * sn + x2 * cs) * sc; }
                bf16_t* rowp = O + (size_t)row * 512 + hc; *(u32x4*)rowp = pack8(o1[0], o1[1]); *(u32x4*)(rowp + 32) = pack8(o2[0], o2[1]); }
        }
        else if (pn < 14) plain<0>(acc, RV, 1024, (pn - 10) * 256, 1.f, row0, col8);
        else if (pn < 18) plain<2>(acc, SG, 1024, (pn - 14) * 256, 1.f, row0, col8);
        else if (pn < 22) plain<3>(acc, GA, 1024, (pn - 18) * 256, 1.f, row0, col8);
        else if (pn < 26) plain<3>(acc, GB, 1024, (pn - 22) * 256, 1.f, row0, col8);
        else if (wc == 0 && fq == 0) {
            const f32x4 b0 = *(const f32x4*)bforget, b1 = *(const f32x4*)(bforget + 4);
            PG8_FOR_AI_M { const int row = row0 + ai * HALF + m * 16; f32x4 a = acc[ai][0][m][0] + b0, b = acc[ai][0][m][1] + b1;
#pragma unroll
                for (int e = 0; e < 4; ++e) { a[e] = logsigmoidf_(a[e]); b[e] = logsigmoidf_(b[e]); }
                *(f32x4*)(LF + (size_t)row * 8) = a; *(f32x4*)(LF + (size_t)row * 8 + 4) = b; }
        }
    }
};

__device__ __forceinline__ float bfe(const u32x4& w, int i) { const unsigned x = w[i >> 1]; return __uint_as_float((i & 1) ? (x & 0xffff0000u) : (x << 16)); }
struct EpiMerge {
    static constexpr bool PERM = true, AFTER_DRAIN = false, HAS_MID = true;
    bf16_t* O; const bf16_t* GA; const bf16_t* GB; int mid_tiles;
    __device__ __forceinline__ void mid(f32x4 (&acc)[2][2][4][2], const Unit& u, int wr, int wc, int fr, int fq) const {
        const int row0 = u.pm * BM + wr * 64 + fr, col0 = u.pn * BM + wc * 32 + 8 * fq;
        unsigned off0 = (unsigned)row0 * 1024u + (unsigned)col0; asm volatile("" : "+v"(off0));
        PG8_FOR_AI_M { const unsigned off = off0 + (unsigned)(ai * HALF + m * 16) * 1024u;
#pragma unroll
            for (int bj = 0; bj < 2; ++bj) { const u32x4 ga = *(const u32x4*)(GA + off + bj * HALF), gb = *(const u32x4*)(GB + off + bj * HALF);
#pragma unroll
                for (int n = 0; n < 2; ++n)
#pragma unroll
                    for (int e = 0; e < 4; ++e) acc[ai][bj][m][n][e] *= bfe(ga, 4 * n + e) * __builtin_amdgcn_rcpf(bfe(gb, 4 * n + e)); }
            asm volatile("" ::: "memory"); }
    }
    __device__ __forceinline__ void operator()(const f32x4 (&acc)[2][2][4][2], const Unit& u, int wr, int wc, int fr, int fq) const {
        const int row0 = u.pm * BM + wr * 64 + fr, col0 = u.pn * BM + wc * 32 + 8 * fq;
        PG8_FOR_AI_M { const size_t off = (size_t)(row0 + ai * HALF + m * 16) * 1024 + col0;
#pragma unroll
            for (int bj = 0; bj < 2; ++bj) { const u32x4 gb = *(const u32x4*)(GB + off + bj * HALF); f32x4 v0 = acc[ai][bj][m][0], v1 = acc[ai][bj][m][1];
#pragma unroll
                for (int e = 0; e < 4; ++e) { v0[e] *= bfe(gb, e); v1[e] *= bfe(gb, 4 + e); }
                *(u32x4*)(O + off + bj * HALF) = pack8(v0, v1); } }
    }
};
struct EpiX1 {
    static constexpr bool PERM = false, AFTER_DRAIN = false, HAS_MID = false;
    const float* X; const float* mod; float* O;
    __device__ __forceinline__ void operator()(const f32x4 (&acc)[2][2][4][2], const Unit& u, int wr, int wc, int fr, int fq) const {
        const int row0 = u.pm * BM + wr * 64 + fr, col0 = u.pn * BM + wc * 32 + 4 * fq; const float* gp = mod + (u.pm >> 4) * 6144 + 2048 + col0;
#pragma unroll
        for (int bj = 0; bj < 2; ++bj)
#pragma unroll
            for (int n = 0; n < 2; ++n) { const f32x4 gate = *(const f32x4*)(gp + bj * HALF + n * 16);
                PG8_FOR_AI_M { const size_t off = (size_t)(row0 + ai * HALF + m * 16) * 1024 + col0 + bj * HALF + n * 16; *(f32x4*)(O + off) = *(const f32x4*)(X + off) + gate * acc[ai][bj][m][n]; } }
    }
};
struct EpiRS {
    static constexpr bool PERM = true, AFTER_DRAIN = false, HAS_MID = false;
    float* SC; bf16_t* HS;
    __device__ __forceinline__ void operator()(const f32x4 (&acc)[2][2][4][2], const Unit& u, int wr, int wc, int fr, int fq) const {
        const int row0 = u.pm * BM + wr * 64 + fr, c8 = wc * 32 + 8 * fq;
        if (u.pn == 0) {
            PG8_FOR_AI_M { float* rp = SC + (size_t)(row0 + ai * HALF + m * 16) * 256 + c8;
#pragma unroll
                for (int bj = 0; bj < 2; ++bj)
#pragma unroll
                    for (int n = 0; n < 2; ++n) *(f32x4*)(rp + bj * HALF + 4 * n) = act4<3>(acc[ai][bj][m][n], 1.f); }
        } else {
            PG8_FOR_AI_M { bf16_t* rp = HS + (size_t)(row0 + ai * HALF + m * 16) * 256 + (u.pn - 1) * HALF + c8;
                *(u32x4*)rp = pack8(act4<2>(acc[ai][0][m][0], 1.f) * acc[ai][1][m][0], act4<2>(acc[ai][0][m][1], 1.f) * acc[ai][1][m][1]); }
        }
    }
};
template <int ldc> struct EpiPlain {
    static constexpr bool PERM = true, AFTER_DRAIN = false, HAS_MID = false;
    bf16_t* O;
    __device__ __forceinline__ void operator()(const f32x4 (&acc)[2][2][4][2], const Unit& u, int wr, int wc, int fr, int fq) const {
        const int row0 = u.pm * BM + wr * 64 + fr, col0 = u.pn * BM + wc * 32 + 8 * fq;
        PG8_FOR_AI_M { bf16_t* rowp = O + (size_t)(row0 + ai * HALF + m * 16) * ldc + col0;
#pragma unroll
            for (int bj = 0; bj < 2; ++bj) *(u32x4*)(rowp + bj * HALF) = pack8(acc[ai][bj][m][0], acc[ai][bj][m][1]); }
    }
};

template <class Epi, class Sched, bool ALIGN_EPI = false, bool SP2 = false>
__device__ __forceinline__ void gemm_phase(PG8_LAS unsigned char* lds, const Gemm g, const Sched& S, const Epi& E, const int wid) {
    const int lane = lane_id_asm(), tid = wid * 64 + lane, wr = wid >> 2, wc = wid & 3, fr = lane & 15, fq = lane >> 4;
    int K = g.K; asm volatile("" : "+s"(K));
    const int nt = K / BK;
    unsigned voffA[2], voffB[2];
#pragma unroll
    for (int i = 0; i < 2; ++i) { int R, C; stage_rc(tid * 16 + i * 8192, R, C); const int Rb = Epi::PERM ? ((R & ~31) + perm32(R & 31)) : R;
        voffA[i] = (unsigned)(R * g.lda + C) * 2u; voffB[i] = (unsigned)(Rb * g.ldb + C) * 2u; }
    const size_t kstep = (size_t)(BK * 2);
    const size_t hstepA = (size_t)HALF * g.lda * 2, hstepB = (size_t)HALF * g.ldb * 2;
    const size_t tstepA = 2 * hstepA, tstepB = 2 * hstepB;
    const unsigned ldsw = (unsigned)wid * 1024u;
    const int aoff = lds_byte(wr * 64 + fr, fq * 8), boff = lds_byte(wc * 32 + fr, fq * 8);
#define PG8_SA(b, h) (((b) * 2 + (h)) * HTB)
#define PG8_SB(b, h) ((4 + (b) * 2 + (h)) * HTB)
#define PG8_STAGE(bufoff, gbase, voff) do { _Pragma("unroll") for (int _i = 0; _i < 2; ++_i) \
        __builtin_amdgcn_global_load_lds((const unsigned*)((const char*)(gbase) + (voff)[_i]), (PG8_LAS unsigned*)(lds + (bufoff) + ldsw + _i * 8192), 16, 0, 0); } while (0)
#define PG8_LDA(dst, b, h) do { _Pragma("unroll") for (int m = 0; m < 4; ++m) _Pragma("unroll") for (int k = 0; k < 2; ++k) dst[m][k] = *(const PG8_LAS bf16x8*)(lds + PG8_SA(b, h) + aoff + m * 2048 + k * 1024); } while (0)
#define PG8_LDB(dst, b, h) do { _Pragma("unroll") for (int n = 0; n < 2; ++n) _Pragma("unroll") for (int k = 0; k < 2; ++k) dst[n][k] = *(const PG8_LAS bf16x8*)(lds + PG8_SB(b, h) + boff + n * 2048 + k * 1024); } while (0)
#define PG8_MMA(ai, bj, At, Bt) do { __builtin_amdgcn_s_setprio(1); _Pragma("unroll") for (int m = 0; m < 4; ++m) _Pragma("unroll") for (int n = 0; n < 2; ++n) _Pragma("unroll") for (int k = 0; k < 2; ++k) \
        acc[ai][bj][m][n] = __builtin_amdgcn_mfma_f32_16x16x32_bf16(Bt[n][k], At[m][k], acc[ai][bj][m][n], 0, 0, 0); __builtin_amdgcn_s_setprio(0); } while (0)
#define PG8_WAIT_V(n) asm volatile("s_waitcnt vmcnt(" #n ")" ::: "memory")
#define PG8_WAIT_L(n) asm volatile("s_waitcnt lgkmcnt(" #n ")" ::: "memory")
#define PG8_BAR __builtin_amdgcn_s_barrier()
#define PG8_SCHED __builtin_amdgcn_sched_barrier(0)
    Unit cur, nxt; int ui = 0;
    if (!S.next(0, cur)) return;
    f32x4 acc[2][2][4][2];
#pragma unroll
    for (int a = 0; a < 2; ++a)
#pragma unroll
        for (int b = 0; b < 2; ++b)
#pragma unroll
            for (int m = 0; m < 4; ++m)
#pragma unroll
                for (int n = 0; n < 2; ++n) acc[a][b][m][n] = (f32x4){0.f, 0.f, 0.f, 0.f};
    bf16x8 At[4][2], B0[2][2], B1[2][2];
    const char* cA = (const char*)g.A + (size_t)cur.pm * tstepA; const char* cB = (const char*)g.Bt + (size_t)cur.pn * tstepB;
    S.a_ready(cur);
    if constexpr (SP2) {
        PG8_STAGE(PG8_SB(0, 0), cB, voffB); PG8_STAGE(PG8_SB(0, 1), cB + hstepB, voffB); PG8_STAGE(PG8_SA(0, 0), cA, voffA); PG8_STAGE(PG8_SA(0, 1), cA + hstepA, voffA);
        if (wr == 1) PG8_BAR;
        PG8_WAIT_V(2); PG8_BAR;
        PG8_STAGE(PG8_SB(1, 0), cB + kstep, voffB); PG8_STAGE(PG8_SA(1, 0), cA + kstep, voffA); PG8_STAGE(PG8_SB(1, 1), cB + hstepB + kstep, voffB);
        PG8_WAIT_V(6); PG8_BAR;
    } else {
        PG8_STAGE(PG8_SB(0, 0), cB, voffB); PG8_STAGE(PG8_SA(0, 0), cA, voffA); PG8_STAGE(PG8_SB(0, 1), cB + hstepB, voffB); PG8_STAGE(PG8_SA(0, 1), cA + hstepA, voffA);
        if (wr == 1) PG8_BAR;
        PG8_WAIT_V(4); PG8_BAR;
        PG8_STAGE(PG8_SB(1, 0), cB + kstep, voffB); PG8_STAGE(PG8_SA(1, 0), cA + kstep, voffA); PG8_STAGE(PG8_SB(1, 1), cB + hstepB + kstep, voffB);
        PG8_WAIT_V(6); PG8_BAR;
    }
    for (;;) {
        const bool has_next = S.next(ui + 1, nxt);
        const char* nA = has_next ? (const char*)g.A + (size_t)nxt.pm * tstepA : cA; const char* nB = has_next ? (const char*)g.Bt + (size_t)nxt.pn * tstepB : cB;
        for (int t = 0; t < nt; t += 2) {
            const bool last = (t == nt - 2);
            const char* a1 = cA + (size_t)(t + 1) * kstep;
            const char* a2 = last ? nA : cA + (size_t)(t + 2) * kstep; const char* b2 = last ? nB : cB + (size_t)(t + 2) * kstep;
            const char* a3 = a2 + kstep; const char* b3 = b2 + kstep;
            if (last && has_next) S.a_ready(nxt);
            if constexpr (SP2) {
            PG8_LDB(B0, 0, 0); PG8_LDB(B1, 0, 1); PG8_SCHED; PG8_LDA(At, 0, 0); PG8_STAGE(PG8_SA(1, 1), a1 + hstepA, voffA);
            PG8_WAIT_V(8); PG8_WAIT_L(0); PG8_BAR; PG8_MMA(0, 0, At, B0); PG8_MMA(0, 1, At, B1); PG8_BAR; PG8_SCHED;
            PG8_LDA(At, 0, 1); PG8_STAGE(PG8_SB(0, 0), b2, voffB); PG8_STAGE(PG8_SB(0, 1), b2 + hstepB, voffB); PG8_STAGE(PG8_SA(0, 0), a2, voffA);
            PG8_WAIT_V(8); PG8_WAIT_L(0); PG8_BAR; PG8_MMA(1, 0, At, B0); PG8_MMA(1, 1, At, B1); PG8_BAR; PG8_SCHED;
            PG8_LDB(B0, 1, 0); PG8_LDB(B1, 1, 1); PG8_SCHED; PG8_LDA(At, 1, 0); PG8_STAGE(PG8_SA(0, 1), a2 + hstepA, voffA);
            PG8_WAIT_V(8); PG8_WAIT_L(0); PG8_BAR; PG8_MMA(0, 0, At, B0); PG8_MMA(0, 1, At, B1); PG8_BAR; PG8_SCHED;
            PG8_LDA(At, 1, 1); PG8_STAGE(PG8_SB(1, 0), b3, voffB); PG8_STAGE(PG8_SB(1, 1), b3 + hstepB, voffB); PG8_STAGE(PG8_SA(1, 0), a3, voffA);
            PG8_WAIT_V(8); PG8_WAIT_L(0); PG8_BAR; PG8_MMA(1, 0, At, B0); PG8_MMA(1, 1, At, B1); PG8_BAR; PG8_SCHED;
            } else {
            PG8_LDB(B0, 0, 0); PG8_SCHED; PG8_LDA(At, 0, 0); PG8_STAGE(PG8_SA(1, 1), a1 + hstepA, voffA);
            PG8_WAIT_L(8); PG8_BAR; PG8_WAIT_L(0); PG8_MMA(0, 0, At, B0); PG8_BAR; PG8_SCHED;
            PG8_LDB(B1, 0, 1); PG8_STAGE(PG8_SB(0, 0), b2, voffB);
            PG8_BAR; PG8_WAIT_L(0); PG8_MMA(0, 1, At, B1); PG8_BAR;
            PG8_LDA(At, 0, 1); PG8_STAGE(PG8_SA(0, 0), a2, voffA);
            PG8_BAR; PG8_WAIT_L(0); PG8_MMA(1, 0, At, B0); PG8_BAR; PG8_SCHED;
            PG8_STAGE(PG8_SB(0, 1), b2 + hstepB, voffB);
            PG8_WAIT_V(6); PG8_BAR; PG8_MMA(1, 1, At, B1); PG8_BAR;
            PG8_LDB(B0, 1, 0); PG8_SCHED; PG8_LDA(At, 1, 0); PG8_STAGE(PG8_SA(0, 1), a2 + hstepA, voffA);
            PG8_WAIT_L(8); PG8_BAR; PG8_WAIT_L(0); PG8_MMA(0, 0, At, B0); PG8_BAR; PG8_SCHED;
            PG8_LDB(B1, 1, 1); PG8_STAGE(PG8_SB(1, 0), b3, voffB);
            PG8_BAR; PG8_WAIT_L(0); PG8_MMA(0, 1, At, B1); PG8_BAR;
            PG8_LDA(At, 1, 1); PG8_STAGE(PG8_SA(1, 0), a3, voffA);
            PG8_BAR; PG8_WAIT_L(0); PG8_MMA(1, 0, At, B0); PG8_BAR; PG8_SCHED;
            PG8_STAGE(PG8_SB(1, 1), b3 + hstepB, voffB);
            PG8_WAIT_V(6); PG8_BAR; PG8_MMA(1, 1, At, B1); PG8_BAR;
            }
            if constexpr (Epi::HAS_MID) { if (t + 2 == E.mid_tiles) E.mid(acc, cur, wr, wc, fr, fq); }
        }
        if constexpr (ALIGN_EPI) { if (wr == 0) PG8_BAR; }
        if constexpr (!Epi::AFTER_DRAIN) { E(acc, cur, wr, wc, fr, fq); S.done(cur); }
        if (!has_next) break;
#pragma unroll
        for (int a = 0; a < 2; ++a)
#pragma unroll
            for (int b = 0; b < 2; ++b)
#pragma unroll
                for (int m = 0; m < 4; ++m)
#pragma unroll
                    for (int n = 0; n < 2; ++n) acc[a][b][m][n] = (f32x4){0.f, 0.f, 0.f, 0.f};
        cur = nxt; cA = nA; cB = nB; ++ui;
        if constexpr (ALIGN_EPI) { if (wr == 1) PG8_BAR; }
    }
    PG8_WAIT_V(0);
    if constexpr (!ALIGN_EPI) { if (wr == 0) PG8_BAR; }
    PG8_BAR;
    if constexpr (Epi::AFTER_DRAIN) { E.fused(acc, cur, wr, wc, fr, fq, lds, wid, lane); S.done(cur); }
#undef PG8_SA
#undef PG8_SB
#undef PG8_STAGE
#undef PG8_LDA
#undef PG8_LDB
#undef PG8_MMA
#undef PG8_WAIT_V
#undef PG8_WAIT_L
#undef PG8_BAR
#undef PG8_SCHED
}
template <class Epi, class Sched>
__device__ __forceinline__ void gemm_phase_gather(PG8_LAS unsigned char* lds, const Gemm g, const Sched& S, const Epi& E, const int wid) {
    const int lane = lane_id_asm(), tid = wid * 64 + lane, wr = wid >> 2, wc = wid & 3, fr = lane & 15, fq = lane >> 4;
    int K = g.K; asm volatile("" : "+s"(K));
    const int nt = K / BK;
    int RA[2]; unsigned cA2[2], voffB[2];
#pragma unroll
    for (int i = 0; i < 2; ++i) { int R, C; stage_rc(tid * 16 + i * 8192, R, C); const int Rb = Epi::PERM ? ((R & ~31) + perm32(R & 31)) : R;
        RA[i] = R; cA2[i] = (unsigned)C * 2u; voffB[i] = (unsigned)(Rb * g.ldb + C) * 2u; }
    const size_t kstep = (size_t)(BK * 2);
    const size_t hstepB = (size_t)HALF * g.ldb * 2, tstepB = 2 * hstepB;
    const unsigned ldsw = (unsigned)wid * 1024u;
    const int aoff = lds_byte(wr * 64 + fr, fq * 8), boff = lds_byte(wc * 32 + fr, fq * 8);
#define PG8_SA(b, h) (((b) * 2 + (h)) * HTB)
#define PG8_SB(b, h) ((4 + (b) * 2 + (h)) * HTB)
#define PG8_STAGE(bufoff, gbase, voff) do { _Pragma("unroll") for (int _i = 0; _i < 2; ++_i) \
        __builtin_amdgcn_global_load_lds((const unsigned*)((const char*)(gbase) + (voff)[_i]), (PG8_LAS unsigned*)(lds + (bufoff) + ldsw + _i * 8192), 16, 0, 0); } while (0)
#define PG8_LDA(dst, b, h) do { _Pragma("unroll") for (int m = 0; m < 4; ++m) _Pragma("unroll") for (int k = 0; k < 2; ++k) dst[m][k] = *(const PG8_LAS bf16x8*)(lds + PG8_SA(b, h) + aoff + m * 2048 + k * 1024); } while (0)
#define PG8_LDB(dst, b, h) do { _Pragma("unroll") for (int n = 0; n < 2; ++n) _Pragma("unroll") for (int k = 0; k < 2; ++k) dst[n][k] = *(const PG8_LAS bf16x8*)(lds + PG8_SB(b, h) + boff + n * 2048 + k * 1024); } while (0)
#define PG8_MMA(ai, bj, At, Bt) do { __builtin_amdgcn_s_setprio(1); _Pragma("unroll") for (int m = 0; m < 4; ++m) _Pragma("unroll") for (int n = 0; n < 2; ++n) _Pragma("unroll") for (int k = 0; k < 2; ++k) \
        acc[ai][bj][m][n] = __builtin_amdgcn_mfma_f32_16x16x32_bf16(Bt[n][k], At[m][k], acc[ai][bj][m][n], 0, 0, 0); __builtin_amdgcn_s_setprio(0); } while (0)
#define PG8_WAIT_V(n) asm volatile("s_waitcnt vmcnt(" #n ")" ::: "memory")
#define PG8_WAIT_L(n) asm volatile("s_waitcnt lgkmcnt(" #n ")" ::: "memory")
#define PG8_BAR __builtin_amdgcn_s_barrier()
#define PG8_SCHED __builtin_amdgcn_sched_barrier(0)
    Unit cur, nxt; int ui = 0;
    if (!S.next(0, cur)) return;
    f32x4 acc[2][2][4][2];
#pragma unroll
    for (int a = 0; a < 2; ++a)
#pragma unroll
        for (int b = 0; b < 2; ++b)
#pragma unroll
            for (int m = 0; m < 4; ++m)
#pragma unroll
                for (int n = 0; n < 2; ++n) acc[a][b][m][n] = (f32x4){0.f, 0.f, 0.f, 0.f};
    bf16x8 At[4][2], B0[2][2], B1[2][2];
    unsigned vA0[2], vA1[2], vN0[2], vN1[2];
#pragma unroll
    for (int i = 0; i < 2; ++i) { vA0[i] = S.row_off(cur, RA[i]) + cA2[i]; vA1[i] = S.row_off(cur, HALF + RA[i]) + cA2[i]; }
    const char* const gA = (const char*)g.A; const char* cB = (const char*)g.Bt + (size_t)cur.pn * tstepB;
    PG8_STAGE(PG8_SB(0, 0), cB, voffB); PG8_STAGE(PG8_SB(0, 1), cB + hstepB, voffB); PG8_STAGE(PG8_SA(0, 0), gA, vA0); PG8_STAGE(PG8_SA(0, 1), gA, vA1);
    if (wr == 1) PG8_BAR;
    PG8_WAIT_V(2); PG8_BAR;
    PG8_STAGE(PG8_SB(1, 0), cB + kstep, voffB); PG8_STAGE(PG8_SA(1, 0), gA + kstep, vA0); PG8_STAGE(PG8_SB(1, 1), cB + hstepB + kstep, voffB);
    PG8_WAIT_V(6); PG8_BAR;
    for (;;) {
        const bool has_next = S.next(ui + 1, nxt);
        const char* nB = has_next ? (const char*)g.Bt + (size_t)nxt.pn * tstepB : cB;
#pragma unroll
        for (int i = 0; i < 2; ++i) { vN0[i] = has_next ? S.row_off(nxt, RA[i]) + cA2[i] : vA0[i]; vN1[i] = has_next ? S.row_off(nxt, HALF + RA[i]) + cA2[i] : vA1[i]; }
        for (int t = 0; t < nt; t += 2) {
            const bool last = (t == nt - 2);
            const char* a1 = gA + (size_t)(t + 1) * kstep;
            const char* a2 = last ? gA : gA + (size_t)(t + 2) * kstep; const char* b2 = last ? nB : cB + (size_t)(t + 2) * kstep;
            const char* a3 = a2 + kstep; const char* b3 = b2 + kstep;
            unsigned vx0[2], vx1[2];
            if (last) { asm volatile("" : "+v"(vN0[0]), "+v"(vN0[1]), "+v"(vN1[0]), "+v"(vN1[1])); vx0[0] = vN0[0]; vx0[1] = vN0[1]; vx1[0] = vN1[0]; vx1[1] = vN1[1]; }
            else { vx0[0] = vA0[0]; vx0[1] = vA0[1]; vx1[0] = vA1[0]; vx1[1] = vA1[1]; }
            PG8_LDB(B0, 0, 0); PG8_LDB(B1, 0, 1); PG8_SCHED; PG8_LDA(At, 0, 0); PG8_STAGE(PG8_SA(1, 1), a1, vA1);
            PG8_WAIT_V(8); PG8_WAIT_L(0); PG8_BAR; PG8_MMA(0, 0, At, B0); PG8_MMA(0, 1, At, B1); PG8_BAR; PG8_SCHED;
            PG8_LDA(At, 0, 1); PG8_STAGE(PG8_SB(0, 0), b2, voffB); PG8_STAGE(PG8_SB(0, 1), b2 + hstepB, voffB); PG8_STAGE(PG8_SA(0, 0), a2, vx0);
            PG8_WAIT_V(8); PG8_WAIT_L(0); PG8_BAR; PG8_MMA(1, 0, At, B0); PG8_MMA(1, 1, At, B1); PG8_BAR; PG8_SCHED;
            PG8_LDB(B0, 1, 0); PG8_LDB(B1, 1, 1); PG8_SCHED; PG8_LDA(At, 1, 0); PG8_STAGE(PG8_SA(0, 1), a2, vx1);
            PG8_WAIT_V(8); PG8_WAIT_L(0); PG8_BAR; PG8_MMA(0, 0, At, B0); PG8_MMA(0, 1, At, B1); PG8_BAR; PG8_SCHED;
            PG8_LDA(At, 1, 1); PG8_STAGE(PG8_SB(1, 0), b3, voffB); PG8_STAGE(PG8_SB(1, 1), b3 + hstepB, voffB); PG8_STAGE(PG8_SA(1, 0), a3, vx0);
            PG8_WAIT_V(8); PG8_WAIT_L(0); PG8_BAR; PG8_MMA(1, 0, At, B0); PG8_MMA(1, 1, At, B1); PG8_BAR; PG8_SCHED;
        }
        if (wr == 0) PG8_BAR;
        E(acc, cur, wr, wc, fr, fq);
        if (!has_next) break;
#pragma unroll
        for (int a = 0; a < 2; ++a)
#pragma unroll
            for (int b = 0; b < 2; ++b)
#pragma unroll
                for (int m = 0; m < 4; ++m)
#pragma unroll
                    for (int n = 0; n < 2; ++n) acc[a][b][m][n] = (f32x4){0.f, 0.f, 0.f, 0.f};
        cur = nxt; cB = nB; ++ui;
#pragma unroll
        for (int i = 0; i < 2; ++i) { vA0[i] = vN0[i]; vA1[i] = vN1[i]; }
        if (wr == 1) PG8_BAR;
    }
    PG8_WAIT_V(0);
    PG8_BAR;
#undef PG8_SA
#undef PG8_SB
#undef PG8_STAGE
#undef PG8_LDA
#undef PG8_LDB
#undef PG8_MMA
#undef PG8_WAIT_V
#undef PG8_WAIT_L
#undef PG8_BAR
#undef PG8_SCHED
}
struct EpiMoeUp {
    static constexpr bool PERM = true, AFTER_DRAIN = false, HAS_MID = false;
    bf16_t* HE;
    __device__ __forceinline__ void operator()(const f32x4 (&acc)[2][2][4][2], const Unit& u, int wr, int wc, int fr, int fq) const {
        const int row0 = u.pm * BM + wr * 64 + fr, c8 = (u.pn & 1) * HALF + wc * 32 + 8 * fq;
        PG8_FOR_AI_M { bf16_t* rp = HE + (size_t)(row0 + ai * HALF + m * 16) * 256 + c8;
            *(u32x4*)rp = pack8(act4<2>(acc[ai][0][m][0], 1.f) * acc[ai][1][m][0], act4<2>(acc[ai][0][m][1], 1.f) * acc[ai][1][m][1]); }
    }
};
struct EpiMoeDown {
    static constexpr bool PERM = true, AFTER_DRAIN = false, HAS_MID = false;
    bf16_t* YS; const int* LTOK; const float* LW; const PG8_LAS int* tabStart; const PG8_LAS int* tabCnt;
    __device__ __forceinline__ void operator()(const f32x4 (&acc)[2][2][4][2], const Unit& u, int wr, int wc, int fr, int fq) const {
        const int e = u.pn >> 2, base = (u.pm - tabStart[e]) * BM, nvalid = tabCnt[e] - base, col0 = (u.pn & 3) * BM + wc * 32 + 8 * fq;
        PG8_FOR_AI_M { const int r = ai * HALF + wr * 64 + m * 16 + fr;
            if (r < nvalid) { const size_t idx = (size_t)e * CAP + base + r; const int id = LTOK[idx]; const float w = LW[idx]; bf16_t* rp = YS + (size_t)id * 1024 + col0;
#pragma unroll
                for (int bj = 0; bj < 2; ++bj) *(u32x4*)(rp + bj * HALF) = pack8(acc[ai][bj][m][0] * w, acc[ai][bj][m][1] * w); } }
    }
};

}

#define XB_TMO      128
#define XB_XCNT(j)  (256  + 64 * (j))
#define XB_XSUB(j)  (1280 + 64 * (j))
#define XB_XGEN(j)  (2304 + 64 * (j))
#define XB_TOP      3328
#define XB_TOPGEN   3392
#define XCD_BAR_WORDS 3456
#define XB_SPIN_CAP (1u << 18)

__device__ __forceinline__ unsigned xb_ld(unsigned* p)              { return __hip_atomic_load(p, __ATOMIC_RELAXED, __HIP_MEMORY_SCOPE_AGENT); }
__device__ __forceinline__ unsigned xb_add(unsigned* p, unsigned v) { return __hip_atomic_fetch_add(p, v, __ATOMIC_RELAXED, __HIP_MEMORY_SCOPE_AGENT); }
__device__ __forceinline__ unsigned xb_xcc_id() { return (unsigned)__builtin_amdgcn_s_getreg((3 << 11) | 20) & 0xFu; }
#define XB_SPIN(cond, bar) do { unsigned _sp = 0; while (cond) { __builtin_amdgcn_s_sleep(1); \
    if ((++_sp & 255u) == 0u) { if (xb_ld(&(bar)[XB_TMO])) break; if (_sp > XB_SPIN_CAP) { atomicAdd(&(bar)[XB_TMO], 1u); break; } } } } while (0)

struct XcdBarrier {
    unsigned* bar; unsigned x;
    volatile LAS unsigned* st;
};

__device__ __forceinline__ XcdBarrier xcd_barrier_post(unsigned* bar, volatile LAS unsigned* st) {
    XcdBarrier b; b.bar = bar; b.x = xb_xcc_id(); b.st = st;
    if (threadIdx.x == 0) (void)xb_add(&bar[XB_XCNT(b.x)], 1u);
    return b;
}
__device__ __forceinline__ void xcd_barrier_complete(unsigned* bar, unsigned x, unsigned& nloc, unsigned& nx) {
    const unsigned G = gridDim.x * gridDim.y * gridDim.z;
    unsigned sum, cnt, mine, sp = 0u;
    for (;;) {
        sum = 0u; cnt = 0u; mine = 0u;
#pragma unroll
        for (unsigned j = 0; j < 16; ++j) { const unsigned c = xb_ld(&bar[XB_XCNT(j)]); sum += c; cnt += (c > 0u) ? 1u : 0u; mine = (j == x) ? c : mine; }
        if (sum == G) break;
        __builtin_amdgcn_s_sleep(1);
        if ((++sp & 255u) == 0u) { if (xb_ld(&bar[XB_TMO])) break; if (sp > XB_SPIN_CAP) { atomicAdd(&bar[XB_TMO], 1u); break; } }
    }
    nloc = mine > 0u ? mine : 1u; nx = cnt > 0u ? cnt : 1u;
}

__device__ __forceinline__ void xcd_barrier(const XcdBarrier& b, const int wave) {
    asm volatile("s_waitcnt vmcnt(0)" ::: "memory");
    __syncthreads();
    if (wave == 0 && lane_id_asm() == 0) {
        unsigned* bar = b.bar;
        __builtin_amdgcn_s_waitcnt(0);
        unsigned nloc = b.st[0], nx = b.st[1];
        if (nloc == 0u) { xcd_barrier_complete(bar, b.x, nloc, nx); b.st[0] = nloc; b.st[1] = nx; }
        const unsigned old = xb_add(&bar[XB_XSUB(b.x)], 1u);
        const unsigned gen = old / nloc;
        if (old + 1u == (gen + 1u) * nloc) {
            __builtin_amdgcn_fence(__ATOMIC_RELEASE, "agent");
            asm volatile("s_waitcnt vmcnt(0)" ::: "memory");
            const unsigned og = xb_add(&bar[XB_TOP], 1u);
            const unsigned tg = og / nx;
            if (og + 1u == (tg + 1u) * nx) xb_add(&bar[XB_TOPGEN], 1u);
            else XB_SPIN(xb_ld(&bar[XB_TOPGEN]) == tg, bar);
            __builtin_amdgcn_fence(__ATOMIC_ACQUIRE, "agent");
            xb_add(&bar[XB_XGEN(b.x)], 1u);
            asm volatile("s_waitcnt vmcnt(0)" ::: "memory");
        } else {
            XB_SPIN(xb_ld(&bar[XB_XGEN(b.x)]) == gen, bar);
            __builtin_amdgcn_fence(__ATOMIC_ACQUIRE, "agent");
            asm volatile("s_waitcnt vmcnt(0)" ::: "memory");
        }
    }
    __syncthreads();
}

#include <hip/hip_bf16.h>
#include <cmath>
namespace attn_body {
using bf16=__hip_bfloat16;
using bf16x8=__attribute__((ext_vector_type(8)))short;
using s16x4=__attribute__((ext_vector_type(4)))short;
using f32x16=__attribute__((ext_vector_type(16)))float;
using f32x4v=__attribute__((ext_vector_type(4)))float;
using u32x4=__attribute__((ext_vector_type(4)))unsigned;
constexpr int BATCH=4,NHEAD=8,SEQ=4096,D=64,DM=NHEAD*D,OPITCH=1536;
constexpr int NW=8,QBLK=32,QB=QBLK*NW,KVBLK=64,NQB=SEQ/QB;
constexpr int ATTN_PITCH=DM, ATTN_UNIT_ROWS=QB;
__device__ __forceinline__ int crow(int r,int hi){return (r&3)+8*(r>>2)+4*hi;}
#define SBAR() __builtin_amdgcn_sched_barrier(0)
__device__ __forceinline__ void cmask(f32x16&p0,f32x16&p1,int jb,int qrel,int hi){
  const float NEG=-INFINITY; int kb=64*jb+4*hi;
  #pragma unroll
  for(int r=0;r<16;++r){int kv=kb+(r&3)+8*(r>>2); if(kv>qrel)p0[r]=NEG; if(kv+32>qrel)p1[r]=NEG;}
}

constexpr int NSLOT=3, SLOTB=8192;
constexpr int LDS_K=0, LDS_V=NSLOT*SLOTB, LDS_WS=2*NSLOT*SLOTB, LDS_OST=LDS_WS+NW*64*4, LDS_F=LDS_OST+NW*4096, LDS_BYTES=LDS_F+SEQ*4;
constexpr float C2=0.125f*1.4426950408889634f;
__device__ __forceinline__ void glds16(const void*gsrc,unsigned lds_dst){unsigned keep;
  asm volatile("s_mov_b32 %0, m0\n\ts_mov_b32 m0, %2\n\ts_nop 0\n\tglobal_load_lds_dwordx4 %1, off\n\ts_mov_b32 m0, %0":"=&s"(keep):"v"(gsrc),"s"(lds_dst):"memory");}
__device__ __forceinline__ float max3f(float a,float b,float c){float r;asm("v_max3_f32 %0, %1, %2, %3":"=v"(r):"v"(a),"v"(b),"v"(c));return r;}
__device__ __forceinline__ float max2f(float a,float b){float r;asm("v_max_f32_e32 %0, %1, %2":"=v"(r):"v"(a),"v"(b));return r;}
__device__ __forceinline__ float fadd_s(float a,float b){float r;asm("v_add_f32_e32 %0, %1, %2":"=v"(r):"v"(a),"v"(b));return r;}
__device__ __forceinline__ float fsub_s(float a,float b){float r;asm("v_sub_f32_e32 %0, %1, %2":"=v"(r):"v"(a),"v"(b));return r;}
typedef float f32x2_t __attribute__((ext_vector_type(2))); typedef __bf16 bf16x2_t __attribute__((ext_vector_type(2)));
__device__ __forceinline__ unsigned cvtpk_s(float lo,float hi){f32x2_t v={lo,hi};bf16x2_t b=__builtin_convertvector(v,bf16x2_t);return __builtin_bit_cast(unsigned,b);}
#define WAIT_BAR(N) asm volatile("s_waitcnt vmcnt(" #N ") lgkmcnt(0)\n\ts_barrier":::"memory")

__device__ __forceinline__ void qkt(f32x16&p0,f32x16&p1,const char*Kslot,const bf16x8*qr,int r32,int hi){
  const char*kb=Kslot+hi*1024+r32*16;
  #pragma unroll
  for(int d0=0;d0<4;++d0){
    const bf16x8 b0=*reinterpret_cast<const bf16x8*>(kb+d0*2048);
    const bf16x8 b1=*reinterpret_cast<const bf16x8*>(kb+d0*2048+512);
    p0=__builtin_amdgcn_mfma_f32_32x32x16_bf16(b0,qr[d0],p0,0,0,0);p1=__builtin_amdgcn_mfma_f32_32x32x16_bf16(b1,qr[d0],p1,0,0,0);}
}
typedef __attribute__((address_space(3))) const char* lds_cptr;
typedef short v4i16_t __attribute__((ext_vector_type(4)));
__device__ __forceinline__ void kload8(bf16x8*kf,lds_cptr kp){
  kf[0]=*(const __attribute__((address_space(3))) bf16x8*)(kp);      kf[1]=*(const __attribute__((address_space(3))) bf16x8*)(kp+512);
  kf[2]=*(const __attribute__((address_space(3))) bf16x8*)(kp+2048); kf[3]=*(const __attribute__((address_space(3))) bf16x8*)(kp+2560);
  kf[4]=*(const __attribute__((address_space(3))) bf16x8*)(kp+4096); kf[5]=*(const __attribute__((address_space(3))) bf16x8*)(kp+4608);
  kf[6]=*(const __attribute__((address_space(3))) bf16x8*)(kp+6144); kf[7]=*(const __attribute__((address_space(3))) bf16x8*)(kp+6656);
}
__device__ __forceinline__ void kload2(bf16x8*kf,lds_cptr kp,int j){ kf[2*j]=*(const __attribute__((address_space(3))) bf16x8*)(kp+j*2048); kf[2*j+1]=*(const __attribute__((address_space(3))) bf16x8*)(kp+j*2048+512); }
__device__ __forceinline__ s16x4 vtr(lds_cptr p){ return __builtin_bit_cast(s16x4,__builtin_amdgcn_ds_read_tr16_b64_v4i16((__attribute__((address_space(3))) v4i16_t*)p)); }
__device__ __forceinline__ float rowmax(const f32x16&p0,const f32x16&p1){
  float a=max3f(p0[0],p0[1],p1[0]),b=max3f(p0[2],p0[3],p1[1]);a=max3f(a,p1[2],p1[3]);
  #pragma unroll
  for(int r=4;r<16;r+=4){a=max3f(a,p0[r],p0[r+1]);b=max3f(b,p0[r+2],p0[r+3]);a=max3f(a,p1[r],p1[r+1]);b=max3f(b,p1[r+2],p1[r+3]);}
  const float m=max2f(a,b);
  auto rr=__builtin_amdgcn_permlane32_swap(__float_as_uint(m),__float_as_uint(m),false,false);
  return max2f(__uint_as_float(rr[0]),__uint_as_float(rr[1]));
}
__device__ __forceinline__ void pv(f32x16*o,int vb,bf16x8 pa0,bf16x8 pa1,bf16x8 pa2,bf16x8 pa3){
  #pragma unroll
  for(int d0=0;d0<2;++d0){s16x4 lo[4],hi[4];
    #pragma unroll
    for(int ks=0;ks<4;++ks){
      asm volatile("ds_read_b64_tr_b16 %0,%1 offset:%c2":"=&v"(lo[ks]):"v"(vb),"i"(d0*4096+ks*1024):"memory");
      asm volatile("ds_read_b64_tr_b16 %0,%1 offset:%c2":"=&v"(hi[ks]):"v"(vb),"i"(d0*4096+ks*1024+512):"memory");}
    asm volatile("s_waitcnt lgkmcnt(0)":::"memory");SBAR();
    #define PK(k) (bf16x8){lo[k][0],lo[k][1],lo[k][2],lo[k][3],hi[k][0],hi[k][1],hi[k][2],hi[k][3]}
    o[d0]=__builtin_amdgcn_mfma_f32_32x32x16_bf16(pa0,PK(0),o[d0],0,0,0);
    o[d0]=__builtin_amdgcn_mfma_f32_32x32x16_bf16(pa1,PK(1),o[d0],0,0,0);
    o[d0]=__builtin_amdgcn_mfma_f32_32x32x16_bf16(pa2,PK(2),o[d0],0,0,0);
    o[d0]=__builtin_amdgcn_mfma_f32_32x32x16_bf16(pa3,PK(3),o[d0],0,0,0);
    #undef PK
  }
}

#ifndef ATTN_STORE16
#define ATTN_STORE16(p,v) (*(u32x4*)(p)=(v))
#endif
template<int THRL> __device__ __forceinline__ void attn_unit(int b,int h,int qb,const bf16*Q,const bf16*__restrict__ K,const bf16*__restrict__ V,bf16*O,const float*__restrict__ F2bh,char*shm,const int wid){
  const int lane=lane_id_asm(),tid=wid*64+lane,r32=lane&31,hi=lane>>5;
  const long rowbase=(long)b*SEQ; const int q0=qb*QB;
  const bf16*Qw=Q+(rowbase+q0+wid*QBLK)*DM+h*D;
  const bf16*Kh=K+rowbase*DM+h*D,*Vh=V+rowbase*DM+h*D;
  const unsigned lds0=(unsigned)(uintptr_t)shm;
  float*wsf=(float*)(shm+LDS_WS)+wid*64;
  const bf16*ksrc=Kh+(long)lane*DM+wid*8;
  const bf16*vsrc=Vh+(long)(16*(wid&3)+(lane>>2))*DM+(wid>>2)*32+(lane&3)*8;
  const unsigned kdst=lds0+LDS_K+wid*1024, vdst=lds0+LDS_V+wid*1024;
  #define DMA_K(t,slot) glds16(ksrc+(long)(t)*KVBLK*DM,(unsigned)__builtin_amdgcn_readfirstlane(kdst+(slot)))
  #define DMA_V(t,slot) glds16(vsrc+(long)(t)*KVBLK*DM,(unsigned)__builtin_amdgcn_readfirstlane(vdst+(slot)))
  const int vb0=(int)(lds0+LDS_V)+((lane>>4)&1)*32+(lane&3)*8+(4*hi+((lane&15)>>2))*64;
  const char*Kbase=shm+LDS_K; bf16x8 kf[8];
  const lds_cptr shm3=(lds_cptr)shm; const lds_cptr kp0=shm3+LDS_K+hi*1024+r32*16; const lds_cptr vp0=shm3+LDS_V+((lane>>4)&1)*32+(lane&3)*8+(4*hi+((lane&15)>>2))*64;
  const int NT=(q0+QB)/KVBLK;
  typedef __attribute__((address_space(3))) f32x4v lds_f4; typedef __attribute__((address_space(3))) const f32x4v lds_cf4;
  { const int nk4=(q0+QB)>>2; const f32x4v*src=(const f32x4v*)F2bh; lds_f4*dstF=(lds_f4*)((__attribute__((address_space(3))) char*)shm+LDS_F);
    for(int i=tid;i<nk4;i+=NW*64)dstF[i]=src[i]; }
  const float fq2=F2bh[q0+wid*QBLK+r32];
  lds_cf4*const fkp=(lds_cf4*)((__attribute__((address_space(3))) const char*)shm+LDS_F)+hi;
  #define FINIT(P,t,half) do{ lds_cf4*fp_=fkp+16*(t)+8*(half); const float base_=fq2-mhat; _Pragma("unroll") for(int g_=0;g_<4;++g_){ const f32x4v a_=fp_[2*g_]; \
      _Pragma("unroll") for(int e_=0;e_<4;++e_) P[4*g_+e_]=base_-a_[e_]; } }while(0)
  DMA_K(0,0);DMA_V(0,0);DMA_K(1,SLOTB);
  bf16x8 qr[4];
  #pragma unroll
  for(int d0=0;d0<4;++d0)qr[d0]=*reinterpret_cast<const bf16x8*>(&Qw[(long)r32*DM+d0*16+hi*8]);
  float mhat=0.f,l_reg=0.f;f32x16 o[2];o[0]=f32x16{};o[1]=f32x16{};
  const int qrel=wid*QBLK+r32;
  #define CMASK(P0,P1,t) do{int jb_=(t)-(NT-4); if(jb_>=0)cmask(P0,P1,jb_,qrel,hi);}while(0)
  bool resc=false;
  #define START(P0,P1) do{ const float rm=rowmax(P0,P1); resc=false; \
    { const float dl=rm; mhat=fadd_s(mhat,dl); \
      _Pragma("unroll") for(int r=0;r<16;++r){P0[r]=fsub_s(P0[r],dl);P1[r]=fsub_s(P1[r],dl);} \
      } \
    _Pragma("unroll") for(int r=0;r<16;++r)P0[r]=__builtin_amdgcn_exp2f(P0[r]); }while(0)
  #define RESC() do{ if(resc){ asm volatile("s_waitcnt lgkmcnt(0)":::"memory"); \
      _Pragma("unroll") for(int d_=0;d_<2;++d_) _Pragma("unroll") for(int r=0;r<16;++r)o[d_][r]*=wsf[crow(r,hi)]; } }while(0)
  f32x16 pA0,pA1,pB0,pB1;
  int sl_prev=0,sl_cur=0,sl_next=SLOTB;
  #define ROT() do{sl_prev=sl_cur;sl_cur=sl_next;sl_next=(sl_next==(NSLOT-1)*SLOTB)?0:sl_next+SLOTB;}while(0)
  DMA_K(2,2*SLOTB);
  WAIT_BAR(3);
  FINIT(pA0,0,0);FINIT(pA1,0,1);qkt(pA0,pA1,Kbase,qr,r32,hi);asm volatile("s_nop 15\n\ts_nop 7":"+v"(pA0),"+v"(pA1));CMASK(pA0,pA1,0);
  START(pA0,pA1);
  _Pragma("unroll") for(int r=0;r<16;++r)pA1[r]=__builtin_amdgcn_exp2f(pA1[r]);
  WAIT_BAR(0);
  DMA_K(3,0);DMA_V(1,SLOTB);
  ROT();
  kload8(kf,kp0+sl_cur);
  WAIT_BAR(2);
  s16x4 vlo[8],vhi[8]; u32x4 pw0,pw1,pw2,pw3;
  #define PKW(P,B) cvtpk_s(P[B],P[B+1])
  #define PAF(k) __builtin_bit_cast(bf16x8,pw##k)
  #define VFR(i) (bf16x8){vlo[i][0],vlo[i][1],vlo[i][2],vlo[i][3],vhi[i][0],vhi[i][1],vhi[i][2],vhi[i][3]}
  #define PIN(x) asm volatile("":"+v"(x))
  #define MX3(a,b,c) __builtin_fmaxf(__builtin_fmaxf((a),(b)),(c))
  #define GAPA(MF,A0,A1,A2,A3,W0,W1,PW) do{ MF; sacc+=A0; sacc+=A1; sacc+=A2; sacc+=A3; PIN(sacc); W0; W1; PIN(PW); SBAR(); }while(0)
  #define EX(v) __builtin_amdgcn_exp2f(v)
  #define GAPB(MF,X,B) do{ MF; X[B]=EX(X[B]); X[B+1]=EX(X[B+1]); X[B+2]=EX(X[B+2]); X[B+3]=EX(X[B+3]); PIN(X); SBAR(); }while(0)
  #define VRD(i) do{ vlo[i]=vtr(vp_+(((i)>>2)*4096+((i)&3)*1024)); vhi[i]=vtr(vp_+(((i)>>2)*4096+((i)&3)*1024+512)); }while(0)
  #define KRD(G,j) do{ if(G){ kload2(kf,kp0+sl_next,j); SBAR(); } }while(0)
  #define STEP(C0,C1,P0,P1,t,GK,GV,GL) do{ SBAR(); \
    const lds_cptr vp_=vp0+sl_prev; \
    FINIT(C0,t,0); SBAR(); VRD(0); SBAR(); float sacc=(P0[0]+P0[1]); \
    GAPA(C0=__builtin_amdgcn_mfma_f32_32x32x16_bf16(kf[0],qr[0],C0,0,0,0), P0[2],P0[3],P0[4],P0[5],     pw0[0]=PKW(P0,0), pw0[1]=PKW(P0,2), pw0); \
    FINIT(C1,t,1); SBAR(); VRD(4); SBAR(); GAPA(C1=__builtin_amdgcn_mfma_f32_32x32x16_bf16(kf[1],qr[0],C1,0,0,0), P0[6],P0[7],P0[8],P0[9],     pw0[2]=PKW(P0,4), pw0[3]=PKW(P0,6), pw0); \
    VRD(1); SBAR(); GAPA(C0=__builtin_amdgcn_mfma_f32_32x32x16_bf16(kf[2],qr[1],C0,0,0,0),   P0[10],P0[11],P0[12],P0[13], pw1[0]=PKW(P0,8), pw1[1]=PKW(P0,10), pw1); \
    VRD(5); SBAR(); GAPA(C1=__builtin_amdgcn_mfma_f32_32x32x16_bf16(kf[3],qr[1],C1,0,0,0),   P0[14],P0[15],P1[0],P1[1],   pw1[2]=PKW(P0,12),pw1[3]=PKW(P0,14), pw1); \
    VRD(2); SBAR(); GAPA(C0=__builtin_amdgcn_mfma_f32_32x32x16_bf16(kf[4],qr[2],C0,0,0,0),   P1[2],P1[3],P1[4],P1[5],     pw2[0]=PKW(P1,0), pw2[1]=PKW(P1,2), pw2); \
    VRD(6); SBAR(); GAPA(C1=__builtin_amdgcn_mfma_f32_32x32x16_bf16(kf[5],qr[2],C1,0,0,0),   P1[6],P1[7],P1[8],P1[9],     pw2[2]=PKW(P1,4), pw2[3]=PKW(P1,6), pw2); \
    VRD(3); SBAR(); GAPA(C0=__builtin_amdgcn_mfma_f32_32x32x16_bf16(kf[6],qr[3],C0,0,0,0),   P1[10],P1[11],P1[12],P1[13], pw3[0]=PKW(P1,8), pw3[1]=PKW(P1,10), pw3); \
    VRD(7); SBAR(); GAPA(C1=__builtin_amdgcn_mfma_f32_32x32x16_bf16(kf[7],qr[3],C1,0,0,0),   P1[14],P1[15],0.f,0.f,       pw3[2]=PKW(P1,12),pw3[3]=PKW(P1,14), pw3); \
    l_reg+=sacc; \
    if(GK){DMA_K((t)+3,sl_cur);} if(GV){DMA_V((t)+1,sl_next);} \
    CMASK(C0,C1,t); \
    { float a=MX3(C0[0],C0[1],C1[0]),b=MX3(C0[2],C0[3],C1[1]); a=MX3(a,C1[2],C1[3]); \
      _Pragma("unroll") for(int r=4;r<16;r+=4){a=MX3(a,C0[r],C0[r+1]);b=MX3(b,C0[r+2],C0[r+3]);a=MX3(a,C1[r],C1[r+1]);b=MX3(b,C1[r+2],C1[r+3]);} \
      float rm=__builtin_fmaxf(a,b); { auto rr=__builtin_amdgcn_permlane32_swap(__float_as_uint(rm),__float_as_uint(rm),false,false); rm=__builtin_fmaxf(__uint_as_float(rr[0]),__uint_as_float(rr[1])); } \
      resc=false; \
      if(__builtin_expect(__any(rm>(float)THRL),0)){ const float dl=__builtin_fmaxf(rm,0.f); mhat+=dl; \
        _Pragma("unroll") for(int r=0;r<16;++r){C0[r]-=dl;C1[r]-=dl;} \
        const float f=__builtin_amdgcn_exp2f(-dl); l_reg*=f; if(hi==0)wsf[r32]=f; resc=true; } } \
    SBAR(); \
    GAPB(o[0]=__builtin_amdgcn_mfma_f32_32x32x16_bf16(PAF(0),VFR(0),o[0],0,0,0), C0,0); \
    GAPB(o[1]=__builtin_amdgcn_mfma_f32_32x32x16_bf16(PAF(0),VFR(4),o[1],0,0,0), C0,4); \
    KRD(GL,0); GAPB(o[0]=__builtin_amdgcn_mfma_f32_32x32x16_bf16(PAF(1),VFR(1),o[0],0,0,0), C0,8); \
    KRD(GL,1); GAPB(o[1]=__builtin_amdgcn_mfma_f32_32x32x16_bf16(PAF(1),VFR(5),o[1],0,0,0), C0,12); \
    KRD(GL,2); GAPB(o[0]=__builtin_amdgcn_mfma_f32_32x32x16_bf16(PAF(2),VFR(2),o[0],0,0,0), C1,0); \
    KRD(GL,3); GAPB(o[1]=__builtin_amdgcn_mfma_f32_32x32x16_bf16(PAF(2),VFR(6),o[1],0,0,0), C1,4); \
    GAPB(o[0]=__builtin_amdgcn_mfma_f32_32x32x16_bf16(PAF(3),VFR(3),o[0],0,0,0), C1,8); \
    GAPB(o[1]=__builtin_amdgcn_mfma_f32_32x32x16_bf16(PAF(3),VFR(7),o[1],0,0,0), C1,12); \
    }while(0)
  int t=1;
  #undef CMASK
  #define CMASK(P0,P1,t) do{}while(0)
  for(;t+5<NT;t+=2){
    STEP(pB0,pB1,pA0,pA1,t,true,true,true);     WAIT_BAR(2); RESC(); ROT();
    STEP(pA0,pA1,pB0,pB1,t+1,true,true,true);   WAIT_BAR(2); RESC(); ROT();
  }
  #undef CMASK
  #define CMASK(P0,P1,t) do{int jb_=(t)-(NT-4); if(jb_>=0)cmask(P0,P1,jb_,qrel,hi);}while(0)
  #define ENDW(tt) do{ if((tt)+3<NT){WAIT_BAR(2);} else if((tt)+2<NT){WAIT_BAR(1);} else {WAIT_BAR(0);} }while(0)
  for(;t+1<NT;t+=2){
    STEP(pB0,pB1,pA0,pA1,t,(t+3<NT),(t+1<NT),(t+1<NT));       ENDW(t);   RESC(); ROT();
    STEP(pA0,pA1,pB0,pB1,t+1,(t+4<NT),(t+2<NT),(t+2<NT));     ENDW(t+1); RESC(); ROT();
  }
  STEP(pB0,pB1,pA0,pA1,NT-1,false,false,false); RESC();
  { float sacc=pB0[0]+pB0[1]; _Pragma("unroll") for(int r=2;r<16;++r)sacc+=pB0[r]; _Pragma("unroll") for(int r=0;r<16;++r)sacc+=pB1[r]; l_reg+=sacc;
    pw0=(u32x4){PKW(pB0,0),PKW(pB0,2),PKW(pB0,4),PKW(pB0,6)};pw1=(u32x4){PKW(pB0,8),PKW(pB0,10),PKW(pB0,12),PKW(pB0,14)};pw2=(u32x4){PKW(pB1,0),PKW(pB1,2),PKW(pB1,4),PKW(pB1,6)};pw3=(u32x4){PKW(pB1,8),PKW(pB1,10),PKW(pB1,12),PKW(pB1,14)};
    SBAR(); pv(o,vb0+sl_cur,PAF(0),PAF(1),PAF(2),PAF(3)); }
  #undef PKW
  #undef PAF
  #undef VFR
  #undef PIN
  #undef MX3
  #undef GAPA
  #undef GAPB
  #undef EX
  #undef VRD
  #undef KRD
  #undef STEP
  #undef ENDW
  {auto rr=__builtin_amdgcn_permlane32_swap(__float_as_uint(l_reg),__float_as_uint(l_reg),false,false);l_reg=__uint_as_float(rr[0])+__uint_as_float(rr[1]);}
  if(hi==0)wsf[32+r32]=l_reg;asm volatile("s_waitcnt lgkmcnt(0)":::"memory");
  float rli[16];
  #pragma unroll
  for(int r=0;r<16;++r)rli[r]=__builtin_amdgcn_rcpf(wsf[32+crow(r,hi)]);
  bf16*Ow=O+(rowbase+q0+wid*QBLK)*OPITCH+h*D;
  { bf16*stg=(bf16*)(shm+LDS_OST)+wid*2048;
    #pragma unroll
    for(int r=0;r<16;++r){const int orow=crow(r,hi);
      #pragma unroll
      for(int d0=0;d0<2;++d0)stg[orow*64+d0*32+r32]=__float2bfloat16(o[d0][r]*rli[r]);}
    asm volatile("s_waitcnt lgkmcnt(0)":::"memory");
    #pragma unroll
    for(int i=0;i<4;++i){const int row=i*8+(lane>>3),ch=lane&7; const u32x4 v=*(const u32x4*)(stg+row*64+ch*8); ATTN_STORE16(Ow+(long)row*OPITCH+ch*8,v);} }
  asm volatile("s_waitcnt lgkmcnt(0)\n\ts_barrier":::"memory");
  #undef FINIT
  #undef DMA_K
  #undef DMA_V
  #undef CMASK
  #undef START
  #undef RESC
  #undef ROT
}
constexpr int ATTN_LDS_BYTES=LDS_BYTES;
struct AttnTensors { const bf16* Q; const bf16* K; const bf16* V; bf16* O; const float* F2; };
struct AttnUnit { int bh; int qb; };
struct StaticOrder {
  int vcu;
  __device__ __forceinline__ explicit StaticOrder(int grid,int block):vcu((block%8)*(grid/8)+block/8){}
  __device__ __forceinline__ bool next(int i,AttnUnit&u)const{ if(i>=2)return false; const int s=vcu&7; u.bh=vcu>>3; u.qb=(i==0)?15-s:s; return true; }
  __device__ __forceinline__ void a_ready(const AttnUnit&)const{}
  __device__ __forceinline__ void done(const AttnUnit&)const{}
};
template<class Sched,int THRL=8> __device__ __forceinline__ void attn_phase(char*lds,const AttnTensors&T,const Sched&S,const int wid){
  AttnUnit u;
  for(int i=0;S.next(i,u);++i){ S.a_ready(u); attn_unit<THRL>(u.bh/NHEAD,u.bh%NHEAD,u.qb,T.Q,T.K,T.V,T.O,T.F2+(long)u.bh*SEQ,lds,wid); S.done(u); }
}
#undef SBAR
#undef WAIT_BAR
}

struct Args {
    const float* in[21]; float* out; unsigned char* ws; int ph_lo, ph_hi; int use_bar, bar_region;
};
struct Frame {
    LAS unsigned char* lds; volatile LAS unsigned* MISC; unsigned* ctl;
    int wave, vcu, G;
};

__device__ __forceinline__ void tr_item(const float* __restrict__ W, int sld, int scol, int nvalid, int k0, bf16_t* __restrict__ dst, int dld, int drow0, int dcol, LAS float* scr, int lane) {
    const int c = lane & 31;
#pragma unroll 8
    for (int i = 0; i < 32; ++i) { const int kk = 2 * i + (lane >> 5); scr[kk * 33 + c] = (c < nvalid) ? W[(size_t)(k0 + kk) * sld + scol + c] : 0.f; }
    LDS_WAIT(); asm volatile("" ::: "memory");
    const int c8 = lane & 7;
#pragma unroll
    for (int j = 0; j < 4; ++j) { const int n = (lane >> 3) + 8 * j; const LAS float* s = scr + (8 * c8) * 33 + n;
        v4u o; o.x = cvt_pk_bf16(s[0 * 33], s[1 * 33]); o.y = cvt_pk_bf16(s[2 * 33], s[3 * 33]); o.z = cvt_pk_bf16(s[4 * 33], s[5 * 33]); o.w = cvt_pk_bf16(s[6 * 33], s[7 * 33]);
        if (n < nvalid) *(v4u*)(dst + (size_t)(drow0 + n) * dld + dcol + k0 + 8 * c8) = o; }
    LDS_WAIT(); asm volatile("" ::: "memory");
}
__device__ __forceinline__ int gu_row(int n, int which, int g) { return 2 * g * (n / g) + which * g + (n % g); }
__device__ __forceinline__ int rope_row(int n) {
    const int which = n >> 9, c = n & 511, tile = c >> 8, cc = c & 255, hl = cc >> 6, d = cc & 63;
    return which * 512 + tile * 256 + 128 * (d >> 5) + 32 * hl + (d & 31);
}

__device__ __forceinline__ void p0_prologue(const Args& a, Frame& F) {
    unsigned char* ws = a.ws; const int lane_ = lane_id_asm(), tid_ = F.wave * 64 + lane_;
    {
        LAS float* sc = (LAS float*)(F.lds);
        LAS float* part = (LAS float*)(F.lds + 16384);
        float* MOD = (float*)(ws + WS_MOD); const float* c = a.in[1]; const float* w_ada = a.in[2]; const float* b_ada = a.in[3];
        for (int it = blockIdx.x; it < 96; it += F.G) {
            for (int i = tid_; i < 4096; i += 512) { const float cv = c[i]; sc[i] = cv / (1.0f + expf(-cv)); }
            __syncthreads();
            const int col = it * 64 + lane_; float acc0 = 0.f, acc1 = 0.f, acc2 = 0.f, acc3 = 0.f;
            for (int d = F.wave * 128; d < F.wave * 128 + 128; ++d) { const float w = w_ada[(size_t)d * 6144 + col]; acc0 += sc[d] * w; acc1 += sc[1024 + d] * w; acc2 += sc[2048 + d] * w; acc3 += sc[3072 + d] * w; }
            part[(F.wave * 4 + 0) * 64 + lane_] = acc0; part[(F.wave * 4 + 1) * 64 + lane_] = acc1; part[(F.wave * 4 + 2) * 64 + lane_] = acc2; part[(F.wave * 4 + 3) * 64 + lane_] = acc3;
            __syncthreads();
            if (tid_ < 256) { const int b = tid_ >> 6, l = tid_ & 63; float s = 0.f;
#pragma unroll
                for (int w = 0; w < 8; ++w) s += part[(w * 4 + b) * 64 + l];
                MOD[b * 6144 + it * 64 + l] = s + b_ada[it * 64 + l]; }
            __syncthreads();
        }
    }
    { float* COS = (float*)(ws + WS_COS); float* SIN = (float*)(ws + WS_SIN);
      for (int idx = blockIdx.x * 512 + tid_; idx < S_ * 32; idx += F.G * 512) { const int pos = idx >> 5, i = idx & 31;
          const float inv = exp2f(-(float)i * (13.287712379549449f / 32.0f)); const float ang = (float)pos * inv; float s, c; sincos_cw(ang, s, c); COS[idx] = c; SIN[idx] = s; } }
    LAS float* scr = (LAS float*)(F.lds + 32768 + F.wave * 8704);
    bf16_t* WIN = (bf16_t*)(ws + WS_WIN); bf16_t* WAB = (bf16_t*)(ws + WS_WAB); bf16_t* WO = (bf16_t*)(ws + WS_WO); bf16_t* WRS = (bf16_t*)(ws + WS_WRS); bf16_t* WSD = (bf16_t*)(ws + WS_WSD);
    bf16_t* WEG = (bf16_t*)(ws + WS_WEG); bf16_t* WED = (bf16_t*)(ws + WS_WED);
    const float* w_in = a.in[5];
    constexpr int J0 = 16 * 48, J1 = 16 * 32, J2 = 16 * 128, J3 = 16, J4 = 8 * 32, J5 = 16 * 32, J6 = 16 * 32, J7 = 16 * 8, J8 = 16 * 8, J9 = 16 * 8, J10 = 4 * 32;
    constexpr int JS = J0 + J1 + J2 + J3 + J4 + J5 + J6 + J7 + J8 + J9 + J10, JE = 128, NITEMS = JS + 3 * NE * JE;
    const int gw = F.vcu * NWAVES + F.wave, NGW = F.G * NWAVES, lane = lane_;
    for (int it = gw; it < NITEMS; it += NGW) {
        int r = it;
        if (r >= JS) {
            r -= JS; const int e = r / (3 * JE), q = r % (3 * JE), kind = q / JE, j = q % JE;
            if (kind < 2) { const int kb = j >> 3, nb = j & 7; tr_item((kind ? a.in[15] : a.in[14]) + (size_t)e * 1024 * 256, 256, nb * 32, 32, kb * 64, WEG + (size_t)e * 512 * 1024, 1024, gu_row(nb * 32, kind, GU_G_E), 0, scr, lane); }
            else { const int kb = j >> 5, nb = j & 31; tr_item(a.in[16] + (size_t)e * 256 * 1024, 1024, nb * 32, 32, kb * 64, WED + (size_t)e * 1024 * 256, 256, nb * 32, 0, scr, lane); }
            continue;
        }
        if (r < J0) { const int kb = r / 48, nb = r % 48; tr_item(w_in, 6664, nb * 32, 32, kb * 64, WIN, 1024, nb * 32, 0, scr, lane); continue; } r -= J0;
        if (r < J1) { const int kb = r / 32, nb = r % 32; tr_item(w_in, 6664, 1544 + nb * 32, 32, kb * 64, WIN, 1024, 1536 + rope_row(nb * 32), 0, scr, lane); continue; } r -= J1;
        if (r < J2) { const int kb = r / 128, nb = r % 128; tr_item(w_in, 6664, 2568 + nb * 32, 32, kb * 64, WIN, 1024, 2560 + nb * 32, 0, scr, lane); continue; } r -= J2;
        if (r < J3) { tr_item(w_in, 6664, 1536, 8, r * 64, WIN, 1024, 6656, 0, scr, lane); continue; } r -= J3;
        if (r < J4) { const int kb = r / 32, nb = r % 32; tr_item(a.in[8], 1024, nb * 32, 32, kb * 64, WAB, 1536, nb * 32, 0, scr, lane); continue; } r -= J4;
        if (r < J5) { const int kb = r / 32, nb = r % 32; tr_item(a.in[9], 1024, nb * 32, 32, kb * 64, WAB, 1536, nb * 32, 512, scr, lane); continue; } r -= J5;
        if (r < J6) { const int kb = r / 32, nb = r % 32; tr_item(a.in[10], 1024, nb * 32, 32, kb * 64, WO, 1024, nb * 32, 0, scr, lane); continue; } r -= J6;
        if (r < J7) { const int kb = r / 8, nb = r % 8; tr_item(a.in[12], 256, nb * 32, 32, kb * 64, WRS, 1024, nb * 32, 0, scr, lane); continue; } r -= J7;
        if (r < J8) { const int kb = r / 8, nb = r % 8; tr_item(a.in[17], 256, nb * 32, 32, kb * 64, WRS, 1024, 256 + gu_row(nb * 32, 0, GU_G_SH), 0, scr, lane); continue; } r -= J8;
        if (r < J9) { const int kb = r / 8, nb = r % 8; tr_item(a.in[18], 256, nb * 32, 32, kb * 64, WRS, 1024, 256 + gu_row(nb * 32, 1, GU_G_SH), 0, scr, lane); continue; } r -= J9;
        { const int kb = r / 32, nb = r % 32; tr_item(a.in[19], 1024, nb * 32, 32, kb * 64, WSD, 256, nb * 32, 0, scr, lane); }
    }
}

__device__ __forceinline__ void norm_mod_rows(const Frame& F, const float* __restrict__ src, const float* __restrict__ g, const float* __restrict__ mod, int shift_off, int scale_off, bf16_t* __restrict__ dst) {
    const int gw = F.vcu * NWAVES + F.wave, NGW = F.G * NWAVES, lane = lane_id_asm();
    f32x4 gv[4];
#pragma unroll
    for (int j = 0; j < 4; ++j) gv[j] = *((const f32x4*)g + lane + 64 * j);
    for (int row = gw; row < T_; row += NGW) {
        const f32x4* xr = (const f32x4*)(src + (size_t)row * D_) + lane; f32x4 v[4]; float s = 0.f;
#pragma unroll
        for (int j = 0; j < 4; ++j) { v[j] = xr[64 * j]; s += (v[j].x * v[j].x + v[j].y * v[j].y) + (v[j].z * v[j].z + v[j].w * v[j].w); }
        const float r = rsqrtf(wave_sum(s) * (1.f / D_) + EPS);
        const float* mb = mod + (row / S_) * 6144; v2u* o8 = (v2u*)(dst + (size_t)row * D_) + lane;
#pragma unroll
        for (int j = 0; j < 4; ++j) { const f32x4 sc = *((const f32x4*)(mb + scale_off) + lane + 64 * j), sh = *((const f32x4*)(mb + shift_off) + lane + 64 * j);
            const f32x4 y = (v[j] * r) * gv[j] * (sc + 1.0f) + sh; v2u w; w.x = cvt_pk_bf16(y[0], y[1]); w.y = cvt_pk_bf16(y[2], y[3]); o8[64 * j] = w; }
    }
}

__device__ __forceinline__ void cumsum_phase(const Frame& F, const float* __restrict__ LF, float* __restrict__ F2) {
    const int gw = F.vcu * NWAVES + F.wave, lane = lane_id_asm(); if (gw >= 32) return;
    const int b = gw >> 3, h = gw & 7; const float* src = LF + ((size_t)b * S_ + lane * 64) * 8 + h;
    float s = 0.f; for (int i = 0; i < 64; ++i) s += src[i * 8];
    float incl = s;
#pragma unroll
    for (int o = 1; o < 64; o <<= 1) { const float t = __shfl_up(incl, o); if (lane >= o) incl += t; }
    float run = incl - s;
    for (int i = 0; i < 64; ++i) { run += src[i * 8]; F2[(size_t)gw * S_ + lane * 64 + i] = run * LOG2E; }
}

namespace ret_body {
typedef short bf16x8 __attribute__((ext_vector_type(8)));
typedef float f32x4 __attribute__((ext_vector_type(4)));
constexpr int QS = 72, VS = 136;
constexpr int LQ = 0, LK = LQ + 128 * QS * 2, LVT = LK + 128 * QS * 2, LPT = LVT + 128 * VS * 2, LCF = LPT + 128 * QS * 2, LDS_BYTES = LCF + 512;
__device__ __forceinline__ float lg2_of(int h) { return log2f(1.0f - exp2f(-5.0f - (float)h)); }
#define RET_MFMA(a, b, c) __builtin_amdgcn_mfma_f32_16x16x32_bf16(a, b, c, 0, 0, 0)
__device__ __forceinline__ void stage_vt(LAS unsigned char* lds, const bf16_t* __restrict__ RV, size_t t0, int h, int tid) {
    LAS bf16_t* VT = (LAS bf16_t*)(lds + LVT);
#pragma unroll
    for (int i = 0; i < 4; ++i) { const int c = tid + 512 * i, j = c & 127, ch = c >> 7; const v4u v = *(const v4u*)(RV + (t0 + j) * 1024 + h * 128 + ch * 8);
#pragma unroll
        for (int x = 0; x < 4; ++x) { VT[(ch * 8 + 2 * x) * VS + j] = (bf16_t)(v[x] & 0xffffu); VT[(ch * 8 + 2 * x + 1) * VS + j] = (bf16_t)(v[x] >> 16); } }
}
__device__ __forceinline__ void r1_unit(LAS unsigned char* lds, const bf16_t* __restrict__ RK, const bf16_t* __restrict__ RV, float* __restrict__ KVNT, int unit, int wid, int lane) {
    const int bh = unit >> 5, n = unit & 31, b = bh >> 3, h = bh & 7, tid = wid * 64 + lane; const size_t t0 = (size_t)b * S_ + n * 128; const float lg2 = lg2_of(h);
    stage_vt(lds, RV, t0, h, tid);
    LAS bf16_t* KZT = (LAS bf16_t*)(lds + LQ);
#pragma unroll
    for (int i = 0; i < 2; ++i) { const int c = tid + 512 * i, j = c & 127, ch = c >> 7; const v4u v = *(const v4u*)(RK + (t0 + j) * 512 + h * 64 + ch * 8); const float z = exp2f((float)(127 - j) * lg2);
#pragma unroll
        for (int x = 0; x < 4; ++x) { KZT[(ch * 8 + 2 * x) * VS + j] = f2bf(__uint_as_float(v[x] << 16) * z); KZT[(ch * 8 + 2 * x + 1) * VS + j] = f2bf(__uint_as_float(v[x] & 0xffff0000u) * z); } }
    __syncthreads();
    const int il = lane & 15, fq = lane >> 4;
    f32x4 acc[4];
#pragma unroll
    for (int db = 0; db < 4; ++db) acc[db] = (f32x4){0.f, 0.f, 0.f, 0.f};
#pragma unroll
    for (int ks = 0; ks < 4; ++ks) { const bf16x8 a = *(const LAS bf16x8*)(lds + LVT + ((16 * wid + il) * VS + 32 * ks + 8 * fq) * 2);
#pragma unroll
        for (int db = 0; db < 4; ++db) { const bf16x8 bq = *(const LAS bf16x8*)(lds + LQ + ((16 * db + il) * VS + 32 * ks + 8 * fq) * 2); acc[db] = RET_MFMA(a, bq, acc[db]); } }
    float* dst = KVNT + ((size_t)unit * 128 + 16 * wid + 4 * fq) * 64 + il;
#pragma unroll
    for (int db = 0; db < 4; ++db)
#pragma unroll
        for (int r = 0; r < 4; ++r) dst[r * 64 + db * 16] = acc[db][r];
    __syncthreads();
}
__device__ __forceinline__ void r2_unit(LAS unsigned char* lds, const bf16_t* __restrict__ RQ, const bf16_t* __restrict__ RK, const bf16_t* __restrict__ RV, const float* __restrict__ PREVT,
                                        const float* __restrict__ gn_g, const bf16_t* __restrict__ SG, bf16_t* __restrict__ AO, int unit, int wid, int lane) {
    const int bh = unit >> 5, n = unit & 31, b = bh >> 3, h = bh & 7, tid = wid * 64 + lane; const size_t t0 = (size_t)b * S_ + n * 128; const float lg2 = lg2_of(h);
    stage_vt(lds, RV, t0, h, tid);
#pragma unroll
    for (int i = 0; i < 2; ++i) { const int c = tid + 512 * i, row = c >> 3, ch = c & 7;
        *(LAS v4u*)(lds + LQ + (row * QS + ch * 8) * 2) = *(const v4u*)(RQ + (t0 + row) * 512 + h * 64 + ch * 8);
        *(LAS v4u*)(lds + LK + (row * QS + ch * 8) * 2) = *(const v4u*)(RK + (t0 + row) * 512 + h * 64 + ch * 8); }
    { const float* pv = PREVT + (size_t)unit * 8192;
#pragma unroll
      for (int i = 0; i < 4; ++i) { const int c = tid + 512 * i, e = c >> 4, d4 = (c & 15) * 4; const f32x4 v = *(const f32x4*)(pv + e * 64 + d4); v2u w; w.x = cvt_pk_bf16(v[0], v[1]); w.y = cvt_pk_bf16(v[2], v[3]);
          *(LAS v2u*)(lds + LPT + (e * QS + d4) * 2) = w; } }
    if (tid < 128) ((LAS float*)(lds + LCF))[tid] = exp2f(-(float)tid * lg2);
    __syncthreads();
    const int il = lane & 15, fq = lane >> 4, i0 = 16 * wid, il_i = i0 + il;
    bf16x8 qf[2];
#pragma unroll
    for (int ks = 0; ks < 2; ++ks) qf[ks] = *(const LAS bf16x8*)(lds + LQ + ((i0 + il) * QS + 32 * ks + 8 * fq) * 2);
    const float rowf = exp2f((float)il_i * lg2);
    f32x4 st[8];
#pragma unroll
    for (int jb = 0; jb < 8; ++jb) {
        st[jb] = (f32x4){0.f, 0.f, 0.f, 0.f};
        if (jb <= wid) {
#pragma unroll
            for (int ks = 0; ks < 2; ++ks) { const bf16x8 kf = *(const LAS bf16x8*)(lds + LK + ((16 * jb + il) * QS + 32 * ks + 8 * fq) * 2); st[jb] = RET_MFMA(kf, qf[ks], st[jb]); }
            const f32x4 cf = *(const LAS f32x4*)(lds + LCF + (16 * jb + 4 * fq) * 4);
#pragma unroll
            for (int r = 0; r < 4; ++r) { const int j = 16 * jb + 4 * fq + r; st[jb][r] = (j <= il_i) ? st[jb][r] * rowf * cf[r] : 0.f; }
        }
    }
    f32x4 oacc[8], cacc[8];
#pragma unroll
    for (int eb = 0; eb < 8; ++eb) { oacc[eb] = (f32x4){0.f, 0.f, 0.f, 0.f}; cacc[eb] = (f32x4){0.f, 0.f, 0.f, 0.f}; }
#pragma unroll
    for (int s = 0; s < 4; ++s) {
        if (2 * s <= wid) {
            v4u pw; pw.x = cvt_pk_bf16(st[2 * s][0], st[2 * s][1]); pw.y = cvt_pk_bf16(st[2 * s][2], st[2 * s][3]); pw.z = cvt_pk_bf16(st[2 * s + 1][0], st[2 * s + 1][1]); pw.w = cvt_pk_bf16(st[2 * s + 1][2], st[2 * s + 1][3]);
            const bf16x8 pb = __builtin_bit_cast(bf16x8, pw);
#pragma unroll
            for (int eb = 0; eb < 8; ++eb) { const LAS unsigned char* vp = lds + LVT + ((16 * eb + il) * VS + 32 * s + 4 * fq) * 2;
                const v2u lo = *(const LAS v2u*)vp, hi = *(const LAS v2u*)(vp + 32); v4u aw; aw.x = lo.x; aw.y = lo.y; aw.z = hi.x; aw.w = hi.y;
                oacc[eb] = RET_MFMA(__builtin_bit_cast(bf16x8, aw), pb, oacc[eb]); }
        }
    }
#pragma unroll
    for (int ks = 0; ks < 2; ++ks)
#pragma unroll
        for (int eb = 0; eb < 8; ++eb) { const bf16x8 pf = *(const LAS bf16x8*)(lds + LPT + ((16 * eb + il) * QS + 32 * ks + 8 * fq) * 2); cacc[eb] = RET_MFMA(pf, qf[ks], cacc[eb]); }
    const float xi = exp2f((float)(il_i + 1) * lg2);
    float s1 = 0.f;
#pragma unroll
    for (int eb = 0; eb < 8; ++eb) { oacc[eb] = oacc[eb] + cacc[eb] * xi; s1 += (oacc[eb][0] + oacc[eb][1]) + (oacc[eb][2] + oacc[eb][3]); }
    s1 += __shfl_xor(s1, 16); s1 += __shfl_xor(s1, 32);
    const float mu = s1 * (1.f / 128.f); float s2 = 0.f;
#pragma unroll
    for (int eb = 0; eb < 8; ++eb) { const f32x4 d = oacc[eb] - mu; s2 += (d[0] * d[0] + d[1] * d[1]) + (d[2] * d[2] + d[3] * d[3]); }
    s2 += __shfl_xor(s2, 16); s2 += __shfl_xor(s2, 32);
    const float rs = rsqrtf(s2 * (1.f / 128.f) + EPS);
    const size_t t = t0 + il_i;
#pragma unroll
    for (int eb = 0; eb < 8; ++eb) { const int e = h * 128 + 16 * eb + 4 * fq; const f32x4 g = *(const f32x4*)(gn_g + e); const v2u sg = *(const v2u*)(SG + t * 1024 + e);
        f32x4 y = (oacc[eb] - mu) * rs * g; y[0] *= __uint_as_float(sg.x << 16); y[1] *= __uint_as_float(sg.x & 0xffff0000u); y[2] *= __uint_as_float(sg.y << 16); y[3] *= __uint_as_float(sg.y & 0xffff0000u);
        v2u w; w.x = cvt_pk_bf16(y[0], y[1]); w.y = cvt_pk_bf16(y[2], y[3]); *(v2u*)(AO + t * 1536 + 512 + e) = w; }
    __syncthreads();
}
#undef RET_MFMA
}

constexpr int TAB_OFF = LDSCTL_OFF + 1024;
struct MoeOrder {
    const LAS int* tabStart; const LAS int* tabCnt; const LAS int* tabE; const int* LTOK; int nunits, pnshift, G, c;
    __device__ __forceinline__ bool next(int i, pg8::Unit& u) const {
        const int L = i * G + c; if (L >= nunits) return false;
        const int blk = L >> pnshift, e = tabE[blk]; u.pm = blk; u.pn = (e << pnshift) + (L & ((1 << pnshift) - 1)); return true;
    }
    __device__ __forceinline__ unsigned row_off(const pg8::Unit& u, int r) const {
        const int e = u.pn >> pnshift, idx = (u.pm - tabStart[e]) * 256 + r; const int id = idx < tabCnt[e] ? LTOK[(size_t)e * CAP + idx] : 0; return (unsigned)(id >> 3) * (unsigned)(D_ * 2);
    }
    __device__ __forceinline__ void a_ready(const pg8::Unit&) const {}
    __device__ __forceinline__ void done(const pg8::Unit&) const {}
};
__device__ __forceinline__ int moe_tables(const Frame& F, const unsigned* __restrict__ CNT) {
    LAS int* tabStart = (LAS int*)(F.lds + TAB_OFF); LAS int* tabCnt = tabStart + 260; LAS int* tabE = tabCnt + 256;
    const int lane = lane_id_asm();
    __syncthreads();
    if (F.wave == 0) {
        int c[4], nb[4], s = 0;
#pragma unroll
        for (int i = 0; i < 4; ++i) { c[i] = (int)__hip_atomic_load(CNT + lane * 4 + i, __ATOMIC_RELAXED, __HIP_MEMORY_SCOPE_AGENT); nb[i] = (c[i] + 255) >> 8; s += nb[i]; }
        int incl = s;
#pragma unroll
        for (int o = 1; o < 64; o <<= 1) { const int t = __shfl_up(incl, o); if (lane >= o) incl += t; }
        int run = incl - s;
#pragma unroll
        for (int i = 0; i < 4; ++i) { tabStart[lane * 4 + i] = run; tabCnt[lane * 4 + i] = c[i]; run += nb[i]; }
        if (lane == 63) tabStart[256] = run;
    }
    __syncthreads();
    const int tid = F.wave * 64 + lane;
    if (tid < 256) { const int b0 = tabStart[tid], b1 = tabStart[tid + 1]; for (int b = b0; b < b1; ++b) tabE[b] = tid; }
    __syncthreads();
    return tabStart[256];
}
__device__ __forceinline__ void route_phase(const Frame& F, const float* __restrict__ SC, const float* __restrict__ rbias, unsigned* __restrict__ CNT, int* __restrict__ LTOK, float* __restrict__ LW) {
    const int gw = F.vcu * NWAVES + F.wave, NGW = F.G * NWAVES, lane = lane_id_asm();
    const f32x4 rb = *((const f32x4*)rbias + lane);
    for (int t = gw; t < T_; t += NGW) {
        const f32x4 sc = *((const f32x4*)(SC + (size_t)t * 256) + lane);
        float sel[4];
#pragma unroll
        for (int i = 0; i < 4; ++i) sel[i] = sc[i] + rb[i];
        float a1 = fmaxf(sel[0], sel[1]), a2 = fminf(sel[0], sel[1]);
        { const float b1 = fmaxf(sel[2], sel[3]), b2 = fminf(sel[2], sel[3]); const float n1 = fmaxf(a1, b1), n2 = fmaxf(fminf(a1, b1), fmaxf(a2, b2)); a1 = n1; a2 = n2; }
#pragma unroll
        for (int o = 1; o < 8; o <<= 1) { const float b1 = __shfl_xor(a1, o), b2 = __shfl_xor(a2, o); const float n1 = fmaxf(a1, b1), n2 = fmaxf(fminf(a1, b1), fmaxf(a2, b2)); a1 = n1; a2 = n2; }
        const float gs = a1 + a2; const int g = lane >> 3; int rank = 0;
#pragma unroll
        for (int gg = 0; gg < 8; ++gg) { const float o = __shfl(gs, gg * 8); rank += (o > gs || (o == gs && gg < g)) ? 1 : 0; }
        const bool allowed = rank < 4;
        float cand[4];
#pragma unroll
        for (int i = 0; i < 4; ++i) cand[i] = allowed ? sel[i] : -INFINITY;
        int myE = 0; float mySc = 0.f;
        for (int r = 0; r < TOPK; ++r) {
            float bv = cand[0]; int bi = lane * 4; float bs = sc[0];
#pragma unroll
            for (int i = 1; i < 4; ++i) if (cand[i] > bv) { bv = cand[i]; bi = lane * 4 + i; bs = sc[i]; }
#pragma unroll
            for (int o = 1; o < 64; o <<= 1) { const float ov = __shfl_xor(bv, o); const int oi = __shfl_xor(bi, o); const float os = __shfl_xor(bs, o);
                if (ov > bv || (ov == bv && oi < bi)) { bv = ov; bi = oi; bs = os; } }
            if ((bi >> 2) == lane) {
#pragma unroll
                for (int i = 0; i < 4; ++i) if ((bi & 3) == i) cand[i] = -INFINITY;
            }
            if (lane == r) { myE = bi; mySc = bs; }
        }
        float tot = (lane < TOPK) ? mySc : 0.f;
#pragma unroll
        for (int o = 1; o < 8; o <<= 1) tot += __shfl_xor(tot, o);
        if (lane < TOPK) { const float w = mySc / tot * 2.5f; const unsigned slot = atomicAdd(&CNT[myE], 1u); LTOK[(size_t)myE * CAP + slot] = t * 8 + lane; LW[(size_t)myE * CAP + slot] = w; }
    }
}
__device__ __forceinline__ void final_rows(const Frame& F, const float* __restrict__ X1, const bf16_t* __restrict__ YS, const bf16_t* __restrict__ SHO, const float* __restrict__ mod, const float* __restrict__ fg, float* __restrict__ out) {
    const int gw = F.vcu * NWAVES + F.wave, NGW = F.G * NWAVES, lane = lane_id_asm();
    for (int row = gw; row < T_; row += NGW) {
        const float* mg = mod + (row / S_) * 6144 + 5120; float v[16]; float s = 0.f;
#pragma unroll
        for (int j = 0; j < 2; ++j) { const int c0 = 8 * lane + 512 * j; float r[8];
            { const v4u w = *(const v4u*)(SHO + (size_t)row * D_ + c0);
#pragma unroll
              for (int x = 0; x < 4; ++x) { r[2 * x] = __uint_as_float(w[x] << 16); r[2 * x + 1] = __uint_as_float(w[x] & 0xffff0000u); } }
#pragma unroll
            for (int k = 0; k < 8; ++k) { const v4u w = *(const v4u*)(YS + ((size_t)row * 8 + k) * D_ + c0);
#pragma unroll
                for (int x = 0; x < 4; ++x) { r[2 * x] += __uint_as_float(w[x] << 16); r[2 * x + 1] += __uint_as_float(w[x] & 0xffff0000u); } }
#pragma unroll
            for (int h = 0; h < 2; ++h) { const f32x4 xv = *(const f32x4*)(X1 + (size_t)row * D_ + c0 + 4 * h), gv = *(const f32x4*)(mg + c0 + 4 * h);
#pragma unroll
                for (int x = 0; x < 4; ++x) { const float y = xv[x] + gv[x] * r[4 * h + x]; v[8 * j + 4 * h + x] = y; s += y * y; } } }
        const float rr = rsqrtf(wave_sum(s) * (1.f / D_) + EPS);
#pragma unroll
        for (int j = 0; j < 2; ++j)
#pragma unroll
            for (int h = 0; h < 2; ++h) { const int c0 = 8 * lane + 512 * j + 4 * h; const f32x4 g = *(const f32x4*)(fg + c0); f32x4 o;
#pragma unroll
                for (int x = 0; x < 4; ++x) o[x] = v[8 * j + 4 * h + x] * rr * g[x];
                *(f32x4*)(out + (size_t)row * D_ + c0) = o; }
    }
}

__global__ void __launch_bounds__(NWAVES * 64, 2) mk_fwd(Args args) {
    extern __shared__ __attribute__((aligned(16))) unsigned char lds[];
    Frame F;
    F.lds = (LAS unsigned char*)lds; F.MISC = (volatile LAS unsigned*)(F.lds + MISC_OFF);
    F.wave = __builtin_amdgcn_readfirstlane(threadIdx.x >> 6);
    F.G = gridDim.x; { const int bx = blockIdx.x; F.vcu = (F.G % 8 == 0) ? (bx % 8) * (F.G / 8) + bx / 8 : bx; }
    unsigned char* ws = args.ws; F.ctl = (unsigned*)(ws + WS_CTL);
    for (int u = threadIdx.x; u < (LDS_BYTES - LDSCTL_OFF) / 4; u += NWAVES * 64) ((LAS unsigned*)(F.lds + LDSCTL_OFF))[u] = 0u;
    __syncthreads();
    unsigned* barw = F.ctl + CW_BAR + args.bar_region * XCD_BAR_WORDS;
    XcdBarrier bar; bar.bar = barw; bar.x = 0; bar.st = nullptr;
    if (args.use_bar) bar = xcd_barrier_post(barw, F.MISC + 8);
    const int lo = args.ph_lo, hi = args.ph_hi;
#ifndef PH_OFF
#define PH_OFF 0
#endif
#define IN(k) (!((PH_OFF >> (k)) & 1) && lo <= (k) && (k) < hi)
#define SEAM(k) do { if (IN(k) && IN((k) + 1)) xcd_barrier(bar, F.wave); } while (0)
    float* MOD = (float*)(ws + WS_MOD); bf16_t* XN = (bf16_t*)(ws + WS_XN);

    if (IN(0)) { p0_prologue(args, F); } SEAM(0);
    if (IN(1)) { norm_mod_rows(F, args.in[0], args.in[4], MOD, 0, 1024, XN); } SEAM(1);
    if (IN(2)) {
        pg8::Gemm g{XN, (const bf16_t*)(ws + WS_WIN), T_, NIN, D_, D_, D_}; pg8::StaticOrder S; S.init(T_, NIN, F.G, (int)blockIdx.x);
        pg8::EpiInproj E{(bf16_t*)(ws + WS_QF), (bf16_t*)(ws + WS_KF), (bf16_t*)(ws + WS_VF), (bf16_t*)(ws + WS_RQ), (bf16_t*)(ws + WS_RK), (bf16_t*)(ws + WS_RV), (bf16_t*)(ws + WS_SG),
                         (bf16_t*)(ws + WS_GA), (bf16_t*)(ws + WS_GB), (float*)(ws + WS_LF), (const float*)(ws + WS_COS), (const float*)(ws + WS_SIN), args.in[6]};
        pg8::gemm_phase<pg8::EpiInproj, pg8::StaticOrder, true, true>(F.lds + RING_OFF, g, S, E, F.wave);
    } SEAM(2);
    if (IN(3)) {
        cumsum_phase(F, (const float*)(ws + WS_LF), (float*)(ws + WS_F2));
        const int lane = lane_id_asm();
        for (int u = blockIdx.x; u < 1024; u += F.G) ret_body::r1_unit(F.lds + RING_OFF, (const bf16_t*)(ws + WS_RK), (const bf16_t*)(ws + WS_RV), (float*)(ws + WS_KVN), u, F.wave, lane);
    } SEAM(3);
    if (IN(4)) {
        float* KV = (float*)(ws + WS_KVN); const int tid = F.wave * 64 + lane_id_asm();
        for (int idx = blockIdx.x * 512 + tid; idx < 32 * 8192; idx += F.G * 512) { const int bh = idx >> 13, r = idx & 8191; const float cd = exp2f(128.f * ret_body::lg2_of(bh & 7)); float st = 0.f;
            float* p = KV + (size_t)bh * 32 * 8192 + r;
            for (int n = 0; n < 32; ++n) { const float tmp = p[(size_t)n * 8192]; p[(size_t)n * 8192] = st; st = cd * st + tmp; } }
    } SEAM(4);
    if (IN(5)) {
        static_assert(attn_body::ATTN_LDS_BYTES <= RING_BYTES && ret_body::LDS_BYTES <= RING_BYTES, "attention / retention LDS");
        const attn_body::AttnTensors AT{(const attn_body::bf16*)(ws + WS_QF), (const attn_body::bf16*)(ws + WS_KF), (const attn_body::bf16*)(ws + WS_VF), (attn_body::bf16*)(ws + WS_AO), (const float*)(ws + WS_F2)};
        const attn_body::StaticOrder S((int)F.G, (int)blockIdx.x);
        attn_body::attn_phase<attn_body::StaticOrder>((char*)lds + RING_OFF, AT, S, F.wave);
        const int lane = lane_id_asm();
        for (int u = blockIdx.x; u < 1024; u += F.G) ret_body::r2_unit(F.lds + RING_OFF, (const bf16_t*)(ws + WS_RQ), (const bf16_t*)(ws + WS_RK), (const bf16_t*)(ws + WS_RV), (const float*)(ws + WS_KVN),
                                                                       args.in[7], (const bf16_t*)(ws + WS_SG), (bf16_t*)(ws + WS_AO), u, F.wave, lane);
    } SEAM(5);
    if (IN(6)) {
        pg8::Gemm g{(const bf16_t*)(ws + WS_AO), (const bf16_t*)(ws + WS_WAB), T_, D_, 1536, 1536, 1536}; pg8::StaticOrder S; S.init(T_, D_, F.G, (int)blockIdx.x);
        pg8::EpiMerge E{(bf16_t*)(ws + WS_MRG), (const bf16_t*)(ws + WS_GA), (const bf16_t*)(ws + WS_GB), 8};
        pg8::gemm_phase<pg8::EpiMerge, pg8::StaticOrder, true, true>(F.lds + RING_OFF, g, S, E, F.wave);
    } SEAM(6);
    if (IN(7)) {
        pg8::Gemm g{(const bf16_t*)(ws + WS_MRG), (const bf16_t*)(ws + WS_WO), T_, D_, D_, D_, D_}; pg8::StaticOrder S; S.init(T_, D_, F.G, (int)blockIdx.x);
        pg8::EpiX1 E{args.in[0], MOD, (float*)(ws + WS_X1)};
        pg8::gemm_phase<pg8::EpiX1, pg8::StaticOrder, true, true>(F.lds + RING_OFF, g, S, E, F.wave);
    } SEAM(7);
    if (IN(8)) { norm_mod_rows(F, (const float*)(ws + WS_X1), args.in[11], MOD, 3072, 4096, XN); } SEAM(8);
    if (IN(9)) {
        pg8::Gemm g{XN, (const bf16_t*)(ws + WS_WRS), T_, 768, D_, D_, D_}; pg8::StaticOrder S; S.init(T_, 768, F.G, (int)blockIdx.x);
        pg8::EpiRS E{(float*)(ws + WS_SCORES), (bf16_t*)(ws + WS_HS)};
        pg8::gemm_phase<pg8::EpiRS, pg8::StaticOrder, true, true>(F.lds + RING_OFF, g, S, E, F.wave);
    } SEAM(9);
    if (IN(10)) {
        pg8::Gemm g{(const bf16_t*)(ws + WS_HS), (const bf16_t*)(ws + WS_WSD), T_, D_, 256, 256, 256}; pg8::StaticOrder S; S.init(T_, D_, F.G, (int)blockIdx.x);
        pg8::EpiPlain<1024> E{(bf16_t*)(ws + WS_MRG)};
        pg8::gemm_phase<pg8::EpiPlain<1024>, pg8::StaticOrder, true, true>(F.lds + RING_OFF, g, S, E, F.wave);
    } SEAM(10);
    if (IN(11)) { route_phase(F, (const float*)(ws + WS_SCORES), args.in[13], F.ctl, (int*)(ws + WS_LTOK), (float*)(ws + WS_LW)); } SEAM(11);
    if (IN(12)) {
        const int nblk = moe_tables(F, F.ctl);
        const LAS int* tabStart = (const LAS int*)(F.lds + TAB_OFF);
        MoeOrder S{tabStart, tabStart + 260, tabStart + 516, (const int*)(ws + WS_LTOK), nblk * 2, 1, F.G, F.vcu};
        pg8::Gemm g{XN, (const bf16_t*)(ws + WS_WEG), 0, 0, D_, D_, D_};
        pg8::EpiMoeUp E{(bf16_t*)(ws + WS_HE)};
        pg8::gemm_phase_gather<pg8::EpiMoeUp, MoeOrder>(F.lds + RING_OFF, g, S, E, F.wave);
    } SEAM(12);
    if (IN(13)) {
        const int nblk = moe_tables(F, F.ctl);
        const LAS int* tabStart = (const LAS int*)(F.lds + TAB_OFF);
        MoeOrder S{tabStart, tabStart + 260, tabStart + 516, (const int*)(ws + WS_LTOK), nblk * 4, 2, F.G, F.vcu};
        pg8::Gemm g{(const bf16_t*)(ws + WS_HE), (const bf16_t*)(ws + WS_WED), 0, 0, 256, 256, 256};
        pg8::EpiMoeDown E{(bf16_t*)(ws + WS_YS), (const int*)(ws + WS_LTOK), (const float*)(ws + WS_LW), tabStart, tabStart + 260};
        pg8::gemm_phase<pg8::EpiMoeDown, MoeOrder, true, true>(F.lds + RING_OFF, g, S, E, F.wave);
    } SEAM(13);
    if (IN(14)) { final_rows(F, (const float*)(ws + WS_X1), (const bf16_t*)(ws + WS_YS), (const bf16_t*)(ws + WS_MRG), MOD, args.in[20], args.out); }
#undef IN
#undef SEAM
}

__global__ void k_norm_mod(const float* __restrict__ x, const float* __restrict__ g, const float* __restrict__ mod, int shift_off, int scale_off, bf16_t* __restrict__ out) {
    const int row = blockIdx.x * 4 + (threadIdx.x >> 6), lane = threadIdx.x & 63; const int b = row / S_;
    const f32x4* xr = (const f32x4*)(x + (long)row * D_) + lane; f32x4 v[4]; float s = 0.f;
#pragma unroll
    for (int j = 0; j < 4; ++j) { v[j] = xr[64 * j]; s += v[j].x * v[j].x + v[j].y * v[j].y + v[j].z * v[j].z + v[j].w * v[j].w; }
    const float r = rsqrtf(wave_sum(s) * (1.f / D_) + EPS);
    const float* mb = mod + b * 6144;
#pragma unroll
    for (int j = 0; j < 4; ++j) {
        const int c0 = 4 * lane + 256 * j;
#pragma unroll
        for (int e = 0; e < 4; ++e) { const int cc = c0 + e; const float y = v[j][e] * r * g[cc]; out[(long)row * D_ + cc] = f2bf(y * (1.f + mb[scale_off + cc]) + mb[shift_off + cc]); }
    }
}

constexpr int LDS_STR = 40;
template <class ARow, class Epi>
__device__ __forceinline__ void gemm128_tile(const ARow& arow, const bf16_t* __restrict__ Bt, int ldb, int K, const Epi& epi, bf16_t* SA, bf16_t* SB) {
    const int tid = threadIdx.x, wid = tid >> 6, lane = tid & 63, wr = wid >> 1, wc = wid & 1, fr = lane & 15, fq = lane >> 4;
    f32x4 acc[4][4];
#pragma unroll
    for (int m = 0; m < 4; ++m)
#pragma unroll
        for (int n = 0; n < 4; ++n) acc[m][n] = (f32x4){0.f, 0.f, 0.f, 0.f};
    const int r0 = tid >> 2, cb = (tid & 3) * 8;
    const bf16_t* ap0 = arow(r0); const bf16_t* ap1 = arow(r0 + 64);
    const unsigned am0 = arow.ok(r0) ? 0xffffffffu : 0u, am1 = arow.ok(r0 + 64) ? 0xffffffffu : 0u;
    const bf16_t* bp0 = Bt + (long)r0 * ldb + cb; const bf16_t* bp1 = Bt + (long)(r0 + 64) * ldb + cb;
    for (int kt = 0; kt < K / 32; ++kt) {
        uint4 va0 = *(const uint4*)(ap0 + kt * 32 + cb), va1 = *(const uint4*)(ap1 + kt * 32 + cb);
        va0.x &= am0; va0.y &= am0; va0.z &= am0; va0.w &= am0; va1.x &= am1; va1.y &= am1; va1.z &= am1; va1.w &= am1;
        const uint4 vb0 = *(const uint4*)(bp0 + kt * 32), vb1 = *(const uint4*)(bp1 + kt * 32);
        __syncthreads();
        *(uint4*)(SA + r0 * LDS_STR + cb) = va0; *(uint4*)(SA + (r0 + 64) * LDS_STR + cb) = va1;
        *(uint4*)(SB + r0 * LDS_STR + cb) = vb0; *(uint4*)(SB + (r0 + 64) * LDS_STR + cb) = vb1;
        __syncthreads();
        bf16x8 a[4], b[4];
#pragma unroll
        for (int m = 0; m < 4; ++m) a[m] = *(const bf16x8*)(SA + (wr * 64 + m * 16 + fr) * LDS_STR + fq * 8);
#pragma unroll
        for (int n = 0; n < 4; ++n) b[n] = *(const bf16x8*)(SB + (wc * 64 + n * 16 + fr) * LDS_STR + fq * 8);
#pragma unroll
        for (int m = 0; m < 4; ++m)
#pragma unroll
            for (int n = 0; n < 4; ++n) acc[m][n] = __builtin_amdgcn_mfma_f32_16x16x32_bf16(a[m], b[n], acc[m][n], 0, 0, 0);
    }
    epi(acc, wr, wc, fr, fq);
}
struct ARowDense { const bf16_t* A; long lda; __device__ __forceinline__ const bf16_t* operator()(int r) const { return A + (long)r * lda; } __device__ __forceinline__ bool ok(int) const { return true; } };

#define EPI_LOOP_MJ _Pragma("unroll") for (int m = 0; m < 4; ++m) _Pragma("unroll") for (int j = 0; j < 4; ++j)
struct DensePtrs { const bf16_t* A; long lda; const bf16_t* Bt; int ldb; int K; int ntn; int mode; bf16_t* O; const bf16_t* G; float* F; const float* X; const float* mod; bf16_t* O2; };
struct EpiDense {
    DensePtrs p; int row0, gc0;
    __device__ __forceinline__ void operator()(const f32x4 (&acc)[4][4], int wr, int wc, int fr, int fq) const {
        if (p.mode == 3 && gc0 >= 256) {
            EPI_LOOP_MJ { const long row = row0 + wr * 64 + m * 16 + fq * 4 + j;
#pragma unroll
                for (int n = 0; n < 2; ++n) { const int jj = ((gc0 - 256) >> 1) + wc * 32 + n * 16 + fr; p.O2[row * 256 + jj] = f2bf(siluf_(acc[m][n][j]) * acc[m][n + 2][j]); } }
        } else if (p.mode == 3) {
            EPI_LOOP_MJ { const long row = row0 + wr * 64 + m * 16 + fq * 4 + j;
#pragma unroll
                for (int n = 0; n < 4; ++n) p.F[row * 256 + gc0 + wc * 64 + n * 16 + fr] = sigmoidf_(acc[m][n][j]); }
        } else if (p.mode == 0) {
            EPI_LOOP_MJ { const long row = row0 + wr * 64 + m * 16 + fq * 4 + j;
#pragma unroll
                for (int n = 0; n < 4; ++n) { const long o = row * 1024 + gc0 + wc * 64 + n * 16 + fr; p.O[o] = f2bf(acc[m][n][j] * bf2f(p.G[o])); } }
        } else if (p.mode == 1) {
            EPI_LOOP_MJ { const long row = row0 + wr * 64 + m * 16 + fq * 4 + j;
#pragma unroll
                for (int n = 0; n < 4; ++n) { const long o = row * 1024 + gc0 + wc * 64 + n * 16 + fr; p.O[o] = f2bf(bf2f(p.O[o]) + acc[m][n][j] * bf2f(p.G[o])); } }
        } else if (p.mode == 2) {
            EPI_LOOP_MJ { const long row = row0 + wr * 64 + m * 16 + fq * 4 + j; const int b = (int)(row / S_);
#pragma unroll
                for (int n = 0; n < 4; ++n) { const int gcol = gc0 + wc * 64 + n * 16 + fr; const long o = row * 1024 + gcol; p.F[o] = p.X[o] + p.mod[b * 6144 + 2048 + gcol] * acc[m][n][j]; } }
        } else {
            EPI_LOOP_MJ { const long row = row0 + wr * 64 + m * 16 + fq * 4 + j;
#pragma unroll
                for (int n = 0; n < 4; ++n) p.O[row * 1024 + gc0 + wc * 64 + n * 16 + fr] = f2bf(acc[m][n][j]); }
        }
    }
};
__global__ __launch_bounds__(256) void k_gemm_dense(DensePtrs p) {
    __shared__ __attribute__((aligned(16))) bf16_t SA[128 * LDS_STR]; __shared__ __attribute__((aligned(16))) bf16_t SB[128 * LDS_STR];
    const int bn = blockIdx.x % p.ntn, bm = blockIdx.x / p.ntn;
    ARowDense ar{p.A + (long)bm * 128 * p.lda, p.lda}; EpiDense e{p, bm * 128, bn * 128};
    gemm128_tile(ar, p.Bt + (long)bn * 128 * p.ldb, p.ldb, p.K, e, SA, SB);
}

__global__ void k_cumsum(const float* __restrict__ LF, float* __restrict__ F2) {
    const int bh = blockIdx.x, b = bh >> 3, h = bh & 7, lane = threadIdx.x;
    const float* src = LF + ((long)b * S_ + lane * 64) * 8 + h;
    float s = 0.f; for (int i = 0; i < 64; ++i) s += src[i * 8];
    float incl = s;
#pragma unroll
    for (int o = 1; o < 64; o <<= 1) { const float t = __shfl_up(incl, o); if (lane >= o) incl += t; }
    float run = incl - s;
    for (int i = 0; i < 64; ++i) { run += src[i * 8]; F2[(long)bh * S_ + lane * 64 + i] = run * LOG2E; }
}

__global__ __launch_bounds__(256) void k_fox_naive(const bf16_t* __restrict__ QF, const bf16_t* __restrict__ KF, const bf16_t* __restrict__ VF, const float* __restrict__ F2, bf16_t* __restrict__ AO) {
    const int gw = blockIdx.x * 4 + (threadIdx.x >> 6), lane = threadIdx.x & 63;
    const int t = gw >> 3, h = gw & 7, b = t / S_, tq = t % S_, bh = b * 8 + h;
    float q[64];
    { const bf16_t* qp = QF + (long)t * 512 + h * 64;
#pragma unroll
      for (int d = 0; d < 64; ++d) q[d] = bf2f(qp[d]); }
    const float fq2 = F2[(long)bh * S_ + tq];
    float o[64];
#pragma unroll
    for (int d = 0; d < 64; ++d) o[d] = 0.f;
    float m = -INFINITY, l = 0.f;
    for (int k = lane; k <= tq; k += 64) {
        const long kr = (long)(b * S_ + k) * 512 + h * 64;
        float s = 0.f;
#pragma unroll
        for (int c = 0; c < 8; ++c) { const uint4 u = *(const uint4*)(KF + kr + c * 8); const unsigned w[4] = {u.x, u.y, u.z, u.w};
#pragma unroll
            for (int e = 0; e < 4; ++e) { s += q[c * 8 + 2 * e] * __uint_as_float(w[e] << 16); s += q[c * 8 + 2 * e + 1] * __uint_as_float(w[e] & 0xffff0000u); } }
        s += fq2 - F2[(long)bh * S_ + k];
        if (s > m) { const float f = exp2f(m - s); l *= f;
#pragma unroll
            for (int d = 0; d < 64; ++d) o[d] *= f;
            m = s; }
        const float p = exp2f(s - m); l += p;
#pragma unroll
        for (int c = 0; c < 8; ++c) { const uint4 u = *(const uint4*)(VF + kr + c * 8); const unsigned w[4] = {u.x, u.y, u.z, u.w};
#pragma unroll
            for (int e = 0; e < 4; ++e) { o[c * 8 + 2 * e] += p * __uint_as_float(w[e] << 16); o[c * 8 + 2 * e + 1] += p * __uint_as_float(w[e] & 0xffff0000u); } }
    }
    float M = m;
#pragma unroll
    for (int off = 1; off < 64; off <<= 1) M = fmaxf(M, __shfl_xor(M, off));
    const float f = (m == -INFINITY) ? 0.f : exp2f(m - M);
    const float lt = wave_sum(l * f); float mine = 0.f;
#pragma unroll
    for (int d = 0; d < 64; ++d) { const float v = wave_sum(o[d] * f); if (lane == d) mine = v; }
    AO[(long)t * 1536 + h * 64 + lane] = f2bf(mine / lt);
}

__device__ __forceinline__ float ret_loggamma(int h) { return log1pf(-exp2f(-5.0f - (float)h)); }
__global__ __launch_bounds__(256) void k_ret_kv(const bf16_t* __restrict__ RK, const bf16_t* __restrict__ RV, float* __restrict__ KVN) {
    __shared__ bf16_t sk[128 * 64]; __shared__ bf16_t sv[128 * 128];
    const int bh = blockIdx.x >> 5, n = blockIdx.x & 31, b = bh >> 3, h = bh & 7, tid = threadIdx.x;
    const long t0 = (long)b * S_ + n * 128;
    for (int i = tid; i < 128 * 64; i += 256) sk[i] = RK[(t0 + (i >> 6)) * 512 + h * 64 + (i & 63)];
    for (int i = tid; i < 128 * 128; i += 256) sv[i] = RV[(t0 + (i >> 7)) * 1024 + h * 128 + (i & 127)];
    __syncthreads();
    const int d = tid >> 2, e0 = (tid & 3) * 32; const float lg = ret_loggamma(h);
    float acc[32];
#pragma unroll
    for (int e = 0; e < 32; ++e) acc[e] = 0.f;
    for (int j = 0; j < 128; ++j) { const float kz = bf2f(sk[j * 64 + d]) * expf((127.f - (float)j) * lg);
#pragma unroll
        for (int e = 0; e < 32; ++e) acc[e] += kz * bf2f(sv[j * 128 + e0 + e]); }
    float* dst = KVN + (((long)bh * 32 + n) * 64 + d) * 128 + e0;
#pragma unroll
    for (int e = 0; e < 32; ++e) dst[e] = acc[e];
}
__global__ void k_ret_scan(float* __restrict__ KVN) {
    const int idx = blockIdx.x * blockDim.x + threadIdx.x; const int bh = idx >> 13, r = idx & 8191, h = bh & 7;
    const float cd = expf(128.f * ret_loggamma(h)); float st = 0.f;
    for (int n = 0; n < 32; ++n) { float* p = KVN + ((long)bh * 32 + n) * 8192 + r; const float tmp = *p; *p = st; st = cd * st + tmp; }
}
__global__ __launch_bounds__(256) void k_ret_out(const bf16_t* __restrict__ RQ, const bf16_t* __restrict__ RK, const bf16_t* __restrict__ RV, const float* __restrict__ PREV,
                                                 const float* __restrict__ gn_g, const bf16_t* __restrict__ SG, bf16_t* __restrict__ AO) {
    __shared__ bf16_t sk[128 * 64]; __shared__ bf16_t sv[128 * 128];
    const int bh = blockIdx.x >> 5, n = blockIdx.x & 31, b = bh >> 3, h = bh & 7, tid = threadIdx.x, i = tid >> 1, e0 = (tid & 1) * 64;
    const long t0 = (long)b * S_ + n * 128;
    for (int x = tid; x < 128 * 64; x += 256) sk[x] = RK[(t0 + (x >> 6)) * 512 + h * 64 + (x & 63)];
    for (int x = tid; x < 128 * 128; x += 256) sv[x] = RV[(t0 + (x >> 7)) * 1024 + h * 128 + (x & 127)];
    __syncthreads();
    const float lg = ret_loggamma(h); const long t = t0 + i;
    float acc[64];
#pragma unroll
    for (int e = 0; e < 64; ++e) acc[e] = 0.f;
    const bf16_t* qp = RQ + t * 512 + h * 64;
    for (int j = 0; j <= i; ++j) {
        float s = 0.f;
#pragma unroll 16
        for (int d = 0; d < 64; ++d) s += bf2f(qp[d]) * bf2f(sk[j * 64 + d]);
        s *= expf((float)(i - j) * lg);
#pragma unroll
        for (int e = 0; e < 64; ++e) acc[e] += s * bf2f(sv[j * 128 + e0 + e]);
    }
    const float xi = expf((float)(i + 1) * lg); const float* pv = PREV + ((long)bh * 32 + n) * 8192 + e0;
    for (int d = 0; d < 64; ++d) { const float qd = bf2f(qp[d]) * xi;
#pragma unroll
        for (int e = 0; e < 64; ++e) acc[e] += qd * pv[d * 128 + e]; }
    float mu = 0.f;
#pragma unroll
    for (int e = 0; e < 64; ++e) mu += acc[e];
    mu += __shfl_xor(mu, 1); mu *= (1.f / 128.f); float var = 0.f;
#pragma unroll
    for (int e = 0; e < 64; ++e) { const float dd = acc[e] - mu; var += dd * dd; }
    var += __shfl_xor(var, 1);
    const float rs = rsqrtf(var * (1.f / 128.f) + EPS);
#pragma unroll
    for (int e = 0; e < 64; ++e) { const float y = (acc[e] - mu) * rs * gn_g[h * 128 + e0 + e]; AO[t * 1536 + 512 + h * 128 + e0 + e] = f2bf(y * bf2f(SG[t * 1024 + h * 128 + e0 + e])); }
}

__global__ __launch_bounds__(256) void k_route(const float* __restrict__ SC, const float* __restrict__ rbias, unsigned* __restrict__ CNT, int* __restrict__ LTOK, float* __restrict__ LW) {
    const int t = blockIdx.x * 4 + (threadIdx.x >> 6), lane = threadIdx.x & 63;
    const f32x4 sc = *((const f32x4*)(SC + (long)t * 256) + lane); const f32x4 rb = *((const f32x4*)rbias + lane);
    float sel[4];
#pragma unroll
    for (int i = 0; i < 4; ++i) sel[i] = sc[i] + rb[i];
    float a1 = fmaxf(sel[0], sel[1]), a2 = fminf(sel[0], sel[1]);
    { const float b1 = fmaxf(sel[2], sel[3]), b2 = fminf(sel[2], sel[3]); const float n1 = fmaxf(a1, b1), n2 = fmaxf(fminf(a1, b1), fmaxf(a2, b2)); a1 = n1; a2 = n2; }
#pragma unroll
    for (int o = 1; o < 8; o <<= 1) { const float b1 = __shfl_xor(a1, o), b2 = __shfl_xor(a2, o); const float n1 = fmaxf(a1, b1), n2 = fmaxf(fminf(a1, b1), fmaxf(a2, b2)); a1 = n1; a2 = n2; }
    const float gs = a1 + a2; const int g = lane >> 3; int rank = 0;
#pragma unroll
    for (int gg = 0; gg < 8; ++gg) { const float o = __shfl(gs, gg * 8); rank += (o > gs || (o == gs && gg < g)) ? 1 : 0; }
    const bool allowed = rank < 4;
    float cand[4];
#pragma unroll
    for (int i = 0; i < 4; ++i) cand[i] = allowed ? sel[i] : -INFINITY;
    int myE = 0; float mySc = 0.f;
    for (int r = 0; r < TOPK; ++r) {
        float bv = cand[0]; int bi = lane * 4; float bs = sc[0];
#pragma unroll
        for (int i = 1; i < 4; ++i) if (cand[i] > bv) { bv = cand[i]; bi = lane * 4 + i; bs = sc[i]; }
#pragma unroll
        for (int o = 1; o < 64; o <<= 1) { const float ov = __shfl_xor(bv, o); const int oi = __shfl_xor(bi, o); const float os = __shfl_xor(bs, o);
            if (ov > bv || (ov == bv && oi < bi)) { bv = ov; bi = oi; bs = os; } }
        if ((bi >> 2) == lane) {
#pragma unroll
            for (int i = 0; i < 4; ++i) if ((bi & 3) == i) cand[i] = -INFINITY;
        }
        if (lane == r) { myE = bi; mySc = bs; }
    }
    float tot = (lane < TOPK) ? mySc : 0.f;
#pragma unroll
    for (int o = 1; o < 8; o <<= 1) tot += __shfl_xor(tot, o);
    if (lane < TOPK) { const float w = mySc / tot * 2.5f; const unsigned slot = atomicAdd(&CNT[myE], 1u); LTOK[(long)myE * CAP + slot] = t * 8 + lane; LW[(long)myE * CAP + slot] = w; }
}
__global__ void k_blocktable(const unsigned* __restrict__ CNT, int* __restrict__ BLK) {
    __shared__ int start[257];
    if (threadIdx.x == 0) { int s = 0; for (int e = 0; e < NE; ++e) { start[e] = s; s += ((int)CNT[e] + 127) >> 7; } start[256] = s; BLK[2048 + 256] = s; }
    __syncthreads();
    const int e = threadIdx.x; BLK[2048 + e] = start[e] * 128;
    for (int b = start[e]; b < start[e + 1]; ++b) BLK[b] = e;
}

struct MoePtrs { const bf16_t* H2; const bf16_t* WEG; const bf16_t* WED; const unsigned* CNT; const int* BLK; const int* LTOK; const float* LW; bf16_t* HE; bf16_t* YS; };
struct ARowGather { const bf16_t* H2; const int* ltok; int valid; __device__ __forceinline__ const bf16_t* operator()(int r) const { return H2 + (long)((r < valid ? ltok[r] : 0) >> 3) * D_; } __device__ __forceinline__ bool ok(int r) const { return r < valid; } };
struct EpiMoeUp {
    bf16_t* HE; long hrow0; int ct;
    __device__ __forceinline__ void operator()(const f32x4 (&acc)[4][4], int wr, int wc, int fr, int fq) const {
#pragma unroll
        for (int m = 0; m < 4; ++m)
#pragma unroll
            for (int j = 0; j < 4; ++j) { const long row = hrow0 + wr * 64 + m * 16 + fq * 4 + j;
#pragma unroll
                for (int n = 0; n < 2; ++n) HE[row * 256 + ct * 64 + wc * 32 + n * 16 + fr] = f2bf(siluf_(acc[m][n][j]) * acc[m][n + 2][j]); }
    }
};
__global__ __launch_bounds__(256) void k_moe_up(MoePtrs p) {
    __shared__ __attribute__((aligned(16))) bf16_t SA[128 * LDS_STR]; __shared__ __attribute__((aligned(16))) bf16_t SB[128 * LDS_STR];
    const int blk = blockIdx.x >> 2, ct = blockIdx.x & 3; if (blk >= p.BLK[2048 + 256]) return;
    const int e = p.BLK[blk], pst = p.BLK[2048 + e], s0 = blk * 128 - pst; int valid = (int)p.CNT[e] - s0; valid = valid > 128 ? 128 : valid;
    ARowGather ar{p.H2, p.LTOK + (long)e * CAP + s0, valid}; EpiMoeUp ep{p.HE, (long)pst + s0, ct};
    gemm128_tile(ar, p.WEG + ((long)e * 512 + ct * 128) * D_, D_, D_, ep, SA, SB);
}
struct EpiMoeDown {
    bf16_t* YS; const int* ltok; const float* lw; int valid, gc0;
    __device__ __forceinline__ void operator()(const f32x4 (&acc)[4][4], int wr, int wc, int fr, int fq) const {
#pragma unroll
        for (int m = 0; m < 4; ++m)
#pragma unroll
            for (int j = 0; j < 4; ++j) { const int r = wr * 64 + m * 16 + fq * 4 + j; if (r < valid) { const long dst = (long)ltok[r] * D_; const float w = lw[r];
#pragma unroll
                for (int n = 0; n < 4; ++n) YS[dst + gc0 + wc * 64 + n * 16 + fr] = f2bf(acc[m][n][j] * w); } }
    }
};
__global__ __launch_bounds__(256) void k_moe_down(MoePtrs p) {
    __shared__ __attribute__((aligned(16))) bf16_t SA[128 * LDS_STR]; __shared__ __attribute__((aligned(16))) bf16_t SB[128 * LDS_STR];
    const int blk = blockIdx.x >> 3, ct = blockIdx.x & 7; if (blk >= p.BLK[2048 + 256]) return;
    const int e = p.BLK[blk], pst = p.BLK[2048 + e], s0 = blk * 128 - pst; int valid = (int)p.CNT[e] - s0; valid = valid > 128 ? 128 : valid;
    ARowDense ar{p.HE + (long)(pst + s0) * 256, 256}; EpiMoeDown ep{p.YS, p.LTOK + (long)e * CAP + s0, p.LW + (long)e * CAP + s0, valid, ct * 128};
    gemm128_tile(ar, p.WED + ((long)e * 1024 + ct * 128) * 256, 256, 256, ep, SA, SB);
}

__global__ void k_final(const float* __restrict__ X1, const bf16_t* __restrict__ YS, const bf16_t* __restrict__ SHO, const float* __restrict__ mod, const float* __restrict__ fg, float* __restrict__ out) {
    const int row = blockIdx.x * 4 + (threadIdx.x >> 6), lane = threadIdx.x & 63; const int b = row / S_;
    float v[16]; float s = 0.f;
#pragma unroll
    for (int j = 0; j < 4; ++j)
#pragma unroll
        for (int e = 0; e < 4; ++e) {
            const int cc = 4 * lane + 256 * j + e; float r = bf2f(SHO[(long)row * D_ + cc]);
#pragma unroll
            for (int k = 0; k < 8; ++k) r += bf2f(YS[((long)row * 8 + k) * D_ + cc]);
            const float y = X1[(long)row * D_ + cc] + mod[b * 6144 + 5120 + cc] * r; v[j * 4 + e] = y; s += y * y;
        }
    const float rr = rsqrtf(wave_sum(s) * (1.f / D_) + EPS);
#pragma unroll
    for (int j = 0; j < 4; ++j)
#pragma unroll
        for (int e = 0; e < 4; ++e) { const int cc = 4 * lane + 256 * j + e; out[(long)row * D_ + cc] = v[j * 4 + e] * rr * fg[cc]; }
}


extern "C" void kernel_launch(void* const* d_in, const int* in_sizes, int n_in, void* d_out, int out_size, void* d_ws, size_t ws_size, hipStream_t stream) {
    static int grid = 0;
    if (grid == 0) {
        if (n_in != 21 || ws_size < WS_END || out_size != T_ * D_) { fprintf(stderr, "kernel_launch: unexpected n_in %d / ws %zu / out %d\n", n_in, ws_size, out_size); grid = -1; return; }
        int dev = 0, cus = 0, per_cu = 0;
        (void)hipGetDevice(&dev); (void)hipDeviceGetAttribute(&cus, hipDeviceAttributeMultiprocessorCount, dev);
        if (hipFuncSetAttribute((const void*)mk_fwd, hipFuncAttributeMaxDynamicSharedMemorySize, LDS_BYTES) != hipSuccess) { fprintf(stderr, "kernel_launch: hipFuncSetAttribute failed\n"); grid = -1; return; }
        if (hipOccupancyMaxActiveBlocksPerMultiprocessor(&per_cu, (const void*)mk_fwd, NWAVES * 64, LDS_BYTES) != hipSuccess || per_cu < 1) { fprintf(stderr, "kernel_launch: occupancy query says %d\n", per_cu); per_cu = 1; }
        (void)hipGetLastError();
        grid = cus;
        if (grid != 256) fprintf(stderr, "kernel_launch: note: %d CUs\n", grid);
    }
    if (grid < 0) return;
    const float* x = (const float*)d_in[0]; const float* ret_gn_g = (const float*)d_in[7]; const float* norm2_g = (const float*)d_in[11];
    const float* router_bias = (const float*)d_in[13]; const float* final_g = (const float*)d_in[20];
    char* ws = (char*)d_ws; float* out = (float*)d_out;
    unsigned* CNT = (unsigned*)(ws + WS_CTL); float* MOD = (float*)(ws + WS_MOD);
    float* F2 = (float*)(ws + WS_F2); float* LF = (float*)(ws + WS_LF); int* BLK = (int*)(ws + WS_BLK);
    bf16_t* WIN = (bf16_t*)(ws + WS_WIN); bf16_t* WAB = (bf16_t*)(ws + WS_WAB); bf16_t* WO = (bf16_t*)(ws + WS_WO); bf16_t* WRS = (bf16_t*)(ws + WS_WRS); bf16_t* WSD = (bf16_t*)(ws + WS_WSD);
    bf16_t* WEG = (bf16_t*)(ws + WS_WEG); bf16_t* WED = (bf16_t*)(ws + WS_WED); bf16_t* XN = (bf16_t*)(ws + WS_XN);
    bf16_t* QF = (bf16_t*)(ws + WS_QF); bf16_t* KF = (bf16_t*)(ws + WS_KF); bf16_t* VF = (bf16_t*)(ws + WS_VF); bf16_t* RQ = (bf16_t*)(ws + WS_RQ); bf16_t* RK = (bf16_t*)(ws + WS_RK);
    bf16_t* RV = (bf16_t*)(ws + WS_RV); bf16_t* SG = (bf16_t*)(ws + WS_SG); bf16_t* GA = (bf16_t*)(ws + WS_GA); bf16_t* GB = (bf16_t*)(ws + WS_GB);
    bf16_t* AO = (bf16_t*)(ws + WS_AO); bf16_t* MRG = (bf16_t*)(ws + WS_MRG); float* X1 = (float*)(ws + WS_X1); float* KVN = (float*)(ws + WS_KVN);
    float* SCORES = (float*)(ws + WS_SCORES); bf16_t* HS = (bf16_t*)(ws + WS_HS); int* LTOK = (int*)(ws + WS_LTOK); float* LW = (float*)(ws + WS_LW);
    bf16_t* HE = (bf16_t*)(ws + WS_HE); bf16_t* YS = (bf16_t*)(ws + WS_YS);

    (void)hipMemsetAsync(ws + WS_CTL, 0, 1 * MiB, stream);
    (void)hipMemsetAsync(WIN + (size_t)6664 * D_, 0, (size_t)(NIN - 6664) * D_ * 2, stream);
    Args a{};
    for (int i = 0; i < 21; ++i) a.in[i] = (const float*)d_in[i];
    a.out = out; a.ws = (unsigned char*)d_ws; a.ph_lo = 0; a.ph_hi = 15; a.use_bar = 1; a.bar_region = 0;
    void* kargs[] = {&a};
    hipError_t le = hipLaunchCooperativeKernel((const void*)mk_fwd, dim3(grid), dim3(NWAVES * 64), kargs, LDS_BYTES, stream);
    if (le != hipSuccess) fprintf(stderr, "kernel_launch: cooperative launch failed: %s\n", hipGetErrorString(le));
}
```

```cpp
#include <hip/hip_runtime.h>
#include <stdint.h>
#include <cstdio>

typedef unsigned short bf16_t;
typedef short bf16x8 __attribute__((ext_vector_type(8)));
typedef float f32x4 __attribute__((ext_vector_type(4)));

constexpr int T_ = 16384, D_ = 1024, S_ = 4096, NBATCH = 4;
constexpr int NIN = 6912;
constexpr int NE = 256, CAP = 16384, TOPK = 8;
constexpr float EPS = 1e-6f;
constexpr float LOG2E = 1.4426950408889634f;
constexpr float C2 = 0.125f * LOG2E;

constexpr size_t MiB = 1u << 20;
constexpr size_t WS_CTL = 0;
constexpr size_t WS_MOD = 1 * MiB;
constexpr size_t WS_COS = 1 * MiB + 256 * 1024;
constexpr size_t WS_SIN = WS_COS + 512 * 1024;
constexpr size_t WS_F2 = 2 * MiB + 512 * 1024;
constexpr size_t WS_LF = 3 * MiB;
constexpr size_t WS_BLK = 3 * MiB + 512 * 1024;
constexpr size_t WS_WIN = 8 * MiB;
constexpr size_t WS_WAB = 22 * MiB;
constexpr size_t WS_WO = 25 * MiB;
constexpr size_t WS_WRS = 27 * MiB;
constexpr size_t WS_WSD = 28 * MiB + 512 * 1024;
constexpr size_t WS_WEG = 32 * MiB;
constexpr size_t WS_WED = 288 * MiB;
constexpr size_t WS_XN = 416 * MiB;
constexpr size_t WS_QF = 448 * MiB, WS_KF = 464 * MiB, WS_VF = 480 * MiB, WS_RQ = 496 * MiB, WS_RK = 512 * MiB;
constexpr size_t WS_RV = 528 * MiB, WS_SG = 560 * MiB, WS_GA = 592 * MiB, WS_GB = 624 * MiB;
constexpr size_t WS_AO = 656 * MiB;
constexpr size_t WS_MRG = 704 * MiB;
constexpr size_t WS_X1 = 736 * MiB;
constexpr size_t WS_KVN = 800 * MiB;
constexpr size_t WS_SCORES = 832 * MiB;
constexpr size_t WS_HS = 848 * MiB;
constexpr size_t WS_LTOK = 860 * MiB;
constexpr size_t WS_LW = 876 * MiB;
constexpr size_t WS_HE = 892 * MiB;
constexpr size_t WS_YS = 448 * MiB;
constexpr size_t WS_END = 988 * MiB;

__device__ __forceinline__ float bf2f(bf16_t v) { return __uint_as_float(((unsigned)v) << 16); }
__device__ __forceinline__ bf16_t f2bf(float f) { unsigned u = __float_as_uint(f); return (bf16_t)((u + 0x7fffu + ((u >> 16) & 1u)) >> 16); }
__device__ __forceinline__ float sigmoidf_(float x) { return 1.0f / (1.0f + __expf(-x)); }
__device__ __forceinline__ float siluf_(float x) { return x / (1.0f + __expf(-x)); }
__device__ __forceinline__ float logsigmoidf_(float x) { return x >= 0.f ? -log1pf(expf(-x)) : x - log1pf(expf(x)); }
__device__ __forceinline__ float wave_sum(float v) {
#pragma unroll
    for (int o = 1; o < 64; o <<= 1) v += __shfl_xor(v, o);
    return v;
}

__device__ __forceinline__ void sincos_cw(float x, float& s, float& c) {
    int j = (int)(x * 1.27323954473516f); float y = (float)j; if (j & 1) { ++j; y += 1.f; }
    j &= 7; float ss = 1.f, cs = 1.f; if (j > 3) { ss = -1.f; cs = -1.f; j -= 4; } if (j > 1) cs = -cs;
    x = ((x - y * 0.78515625f) - y * 2.4187564849853515625e-4f) - y * 3.77489497744594108e-8f;
    const float z = x * x;
    const float ps = ((-1.9515295891e-4f * z + 8.3321608736e-3f) * z - 1.6666654611e-1f) * z * x + x;
    const float pc = ((2.443315711809948e-5f * z - 1.388731625493765e-3f) * z + 4.166664568298827e-2f) * z * z - 0.5f * z + 1.0f;
    if (j == 2) { s = ss * pc; c = cs * ps; } else { s = ss * ps; c = cs * pc; }
}
#define GAS __attribute__((address_space(1)))
#define LAS __attribute__((address_space(3)))
typedef unsigned v4u __attribute__((ext_vector_type(4)));
typedef unsigned v2u __attribute__((ext_vector_type(2)));
#define LDS_WAIT() asm volatile("s_waitcnt lgkmcnt(0)" ::: "memory")
#define VM_WAIT() asm volatile("s_waitcnt vmcnt(0)" ::: "memory")
typedef float f32x2_t __attribute__((ext_vector_type(2))); typedef __bf16 bf16x2_t __attribute__((ext_vector_type(2)));
__device__ __forceinline__ unsigned cvt_pk_bf16(float lo, float hi) { f32x2_t v = {lo, hi}; bf16x2_t b = __builtin_convertvector(v, bf16x2_t); return __builtin_bit_cast(unsigned, b); }
__device__ __forceinline__ float fast_sigmoid(float x) { return __builtin_amdgcn_rcpf(1.0f + __builtin_amdgcn_exp2f(-LOG2E * x)); }
__device__ __forceinline__ float fast_silu(float x) { return x * fast_sigmoid(x); }

__device__ __forceinline__ int lane_id_asm() { int l; asm volatile("v_mbcnt_lo_u32_b32 %0, -1, 0\n\tv_mbcnt_hi_u32_b32 %0, -1, %0" : "=v"(l)); return l; }
constexpr int NWAVES = 8;
constexpr int RING_OFF = 0, RING_BYTES = 131072;
constexpr int LDSCTL_OFF = RING_BYTES, MISC_OFF = LDSCTL_OFF + 320;
constexpr int LDS_BYTES = 147456;
constexpr int CW_CNT = 65536, CNT_STRIDE = 64;
constexpr int CW_NRM = 98304;
constexpr int CW_QUEUE = 3072;
constexpr int CW_BAR = 4096;
constexpr int GU_G_SH = 128;
constexpr int GU_G_E = 128;

namespace pg8 {
#define PG8_LAS __attribute__((address_space(3)))
typedef unsigned short bf16_t;
typedef short bf16x8 __attribute__((ext_vector_type(8)));
typedef float f32x4 __attribute__((ext_vector_type(4)));
typedef unsigned u32x4 __attribute__((ext_vector_type(4)));
constexpr int BM = 256, BK = 64, HALF = 128, HTB = HALF * BK * 2  , STAGE_BYTES = 8 * HTB, NXCD = 8, WGM = 8;

__host__ __device__ __forceinline__ int lds_byte(int r, int c) { const int st = (r >> 4) * 2 + (c >> 5), rr = r & 15, cc = c & 31, ob = rr * 64 + cc * 2; return st * 1024 + (ob ^ (((ob >> 9) & 1) << 5)); }
__host__ __device__ __forceinline__ void stage_rc(int b, int& R, int& C) { const int st = b / 1024, sb = b % 1024, swz = sb ^ (((sb >> 9) & 1) << 5); R = (st >> 1) * 16 + swz / 64; C = (st & 1) * 32 + (swz % 64) / 2; }
__host__ __device__ __forceinline__ int perm32(int rho) { const int n = rho >> 4, i = rho & 15; return 8 * (i >> 2) + 4 * n + (i & 3); }

struct Unit { int pm, pn; };
struct Gemm { const bf16_t* A; const bf16_t* Bt; int M, N, K, lda, ldb; };

struct StaticOrder {
    int nM, nN, nwg, G, c;
    __host__ __device__ void init(int M, int N, int G_, int c_) { nM = M / BM; nN = N / BM; nwg = nM * nN; G = G_; c = c_; }
    __host__ __device__ bool next(int i, Unit& u) const {
        const long L = (long)i * G + c; if (L >= nwg) return false;
        int wgid = (int)L; { const int q = nwg / NXCD, r = nwg % NXCD, xcd = wgid % NXCD, off = wgid / NXCD; wgid = (xcd < r ? xcd * (q + 1) : r * (q + 1) + (xcd - r) * q) + off; }
        const int nig = WGM * nN, gid = wgid / nig, fm = gid * WGM, gsz = (nM - fm) < WGM ? (nM - fm) : WGM;
        u.pm = fm + ((wgid % nig) % gsz); u.pn = (wgid % nig) / gsz; return true;
    }
    __device__ __forceinline__ void a_ready(const Unit&) const {}
    __device__ __forceinline__ void done(const Unit&) const {}
};

#define PG8_FOR_AI_M _Pragma("unroll") for (int ai = 0; ai < 2; ++ai) _Pragma("unroll") for (int m = 0; m < 4; ++m)
__device__ __forceinline__ u32x4 pack8(const f32x4& v0, const f32x4& v1) { u32x4 w; w.x = cvt_pk_bf16(v0[0], v0[1]); w.y = cvt_pk_bf16(v0[2], v0[3]); w.z = cvt_pk_bf16(v1[0], v1[1]); w.w = cvt_pk_bf16(v1[2], v1[3]); return w; }
template <int ACT> __device__ __forceinline__ f32x4 act4(f32x4 v, float sc) {
    if (ACT == 1) { v = v * sc; }
    else if (ACT == 2) { v[0] = fast_silu(v[0]); v[1] = fast_silu(v[1]); v[2] = fast_silu(v[2]); v[3] = fast_silu(v[3]); }
    else if (ACT == 3) { v[0] = fast_sigmoid(v[0]); v[1] = fast_sigmoid(v[1]); v[2] = fast_sigmoid(v[2]); v[3] = fast_sigmoid(v[3]); }
    return v;
}
struct EpiInproj {
    static constexpr bool PERM = true, AFTER_DRAIN = false, HAS_MID = false;
    bf16_t *QF, *KF, *VF, *RQ, *RK, *RV, *SG, *GA, *GB; float* LF; const float *COS, *SIN, *bforget;
    template <int ACT> __device__ __forceinline__ void plain(const f32x4 (&acc)[2][2][4][2], bf16_t* O, int ldc, int colt, float sc, int row0, int col8) const {
        PG8_FOR_AI_M { bf16_t* rowp = O + (size_t)(row0 + ai * HALF + m * 16) * ldc + colt + col8;
#pragma unroll
            for (int bj = 0; bj < 2; ++bj) *(u32x4*)(rowp + bj * HALF) = pack8(act4<ACT>(acc[ai][bj][m][0], sc), act4<ACT>(acc[ai][bj][m][1], sc)); }
    }
    __device__ __forceinline__ void operator()(const f32x4 (&acc)[2][2][4][2], const Unit& u, int wr, int wc, int fr, int fq) const {
        const int pn = u.pn, row0 = u.pm * BM + wr * 64 + fr, col8 = wc * 32 + 8 * fq;
        if (pn < 2) plain<1>(acc, QF, 512, pn * 256, C2, row0, col8);
        else if (pn < 4) plain<0>(acc, KF, 512, (pn - 2) * 256, 1.f, row0, col8);
        else if (pn < 6) plain<0>(acc, VF, 512, (pn - 4) * 256, 1.f, row0, col8);
        else if (pn < 10) {
            const bool isq = pn < 8; bf16_t* O = isq ? RQ : RK; const float sc = isq ? 1.f : 0.125f; const int hc = (4 * (pn & 1) + wc) * 64 + 8 * fq;
            PG8_FOR_AI_M { const int row = row0 + ai * HALF + m * 16, pos = row & (S_ - 1);
                f32x4 o1[2], o2[2];
#pragma unroll
                for (int n = 0; n < 2; ++n) { const f32x4 cs = *(const f32x4*)(COS + pos * 32 + 8 * fq + 4 * n), sn = *(const f32x4*)(SIN + pos * 32 + 8 * fq + 4 * n);
                    const f32x4 x1 = acc[ai][0][m][n], x2 = acc[ai][1][m][n]; o1[n] = (x1 * cs - x2 * sn) * sc; o2[n] = (x1 * sn + x2 * cs) * sc; }
                bf16_t* rowp = O + (size_t)row * 512 + hc; *(u32x4*)rowp = pack8(o1[0], o1[1]); *(u32x4*)(rowp + 32) = pack8(o2[0], o2[1]); }
        }
        else if (pn < 14) plain<0>(acc, RV, 1024, (pn - 10) * 256, 1.f, row0, col8);
        else if (pn < 18) plain<2>(acc, SG, 1024, (pn - 14) * 256, 1.f, row0, col8);
        else if (pn < 22) plain<3>(acc, GA, 1024, (pn - 18) * 256, 1.f, row0, col8);
        else if (pn < 26) plain<3>(acc, GB, 1024, (pn - 22) * 256, 1.f, row0, col8);
        else if (wc == 0 && fq == 0) {
            const f32x4 b0 = *(const f32x4*)bforget, b1 = *(const f32x4*)(bforget + 4);
            PG8_FOR_AI_M { const int row = row0 + ai * HALF + m * 16; f32x4 a = acc[ai][0][m][0] + b0, b = acc[ai][0][m][1] + b1;
                float* lp = LF + (size_t)(row >> 12) * 8 * S_ + (row & (S_ - 1));
#pragma unroll
                for (int e = 0; e < 4; ++e) { lp[(size_t)e * S_] = logsigmoidf_(a[e]); lp[(size_t)(4 + e) * S_] = logsigmoidf_(b[e]); } }
        }
    }
};

__device__ __forceinline__ float bfe(const u32x4& w, int i) { const unsigned x = w[i >> 1]; return __uint_as_float((i & 1) ? (x & 0xffff0000u) : (x << 16)); }
struct EpiMerge {
    static constexpr bool PERM = true, AFTER_DRAIN = false, HAS_MID = true;
    bf16_t* O; const bf16_t* GA; const bf16_t* GB; int mid_tiles;
    __device__ __forceinline__ void mid(f32x4 (&acc)[2][2][4][2], const Unit& u, int wr, int wc, int fr, int fq) const {
        const int row0 = u.pm * BM + wr * 64 + fr, col0 = u.pn * BM + wc * 32 + 8 * fq;
        unsigned off0 = (unsigned)row0 * 1024u + (unsigned)col0; asm volatile("" : "+v"(off0));
        PG8_FOR_AI_M { const unsigned off = off0 + (unsigned)(ai * HALF + m * 16) * 1024u;
#pragma unroll
            for (int bj = 0; bj < 2; ++bj) { const u32x4 ga = *(const u32x4*)(GA + off + bj * HALF), gb = *(const u32x4*)(GB + off + bj * HALF);
#pragma unroll
                for (int n = 0; n < 2; ++n)
#pragma unroll
                    for (int e = 0; e < 4; ++e) acc[ai][bj][m][n][e] *= bfe(ga, 4 * n + e) * __builtin_amdgcn_rcpf(bfe(gb, 4 * n + e)); }
            asm volatile("" ::: "memory"); }
    }
    __device__ __forceinline__ void operator()(const f32x4 (&acc)[2][2][4][2], const Unit& u, int wr, int wc, int fr, int fq) const {
        const int row0 = u.pm * BM + wr * 64 + fr, col0 = u.pn * BM + wc * 32 + 8 * fq;
        PG8_FOR_AI_M { const size_t off = (size_t)(row0 + ai * HALF + m * 16) * 1024 + col0;
#pragma unroll
            for (int bj = 0; bj < 2; ++bj) { const u32x4 gb = *(const u32x4*)(GB + off + bj * HALF); f32x4 v0 = acc[ai][bj][m][0], v1 = acc[ai][bj][m][1];
#pragma unroll
                for (int e = 0; e < 4; ++e) { v0[e] *= bfe(gb, e); v1[e] *= bfe(gb, 4 + e); }
                *(u32x4*)(O + off + bj * HALF) = pack8(v0, v1); } }
    }
};
struct EpiX1 {
    static constexpr bool PERM = false, AFTER_DRAIN = false, HAS_MID = false;
    const float* X; const float* mod; float* O;
    __device__ __forceinline__ void operator()(const f32x4 (&acc)[2][2][4][2], const Unit& u, int wr, int wc, int fr, int fq) const {
        const int row0 = u.pm * BM + wr * 64 + fr, col0 = u.pn * BM + wc * 32 + 4 * fq; const float* gp = mod + (u.pm >> 4) * 6144 + 2048 + col0;
#pragma unroll
        for (int bj = 0; bj < 2; ++bj)
#pragma unroll
            for (int n = 0; n < 2; ++n) { const f32x4 gate = *(const f32x4*)(gp + bj * HALF + n * 16);
                PG8_FOR_AI_M { const size_t off = (size_t)(row0 + ai * HALF + m * 16) * 1024 + col0 + bj * HALF + n * 16; *(f32x4*)(O + off) = *(const f32x4*)(X + off) + gate * acc[ai][bj][m][n]; } }
    }
};
struct EpiRS {
    static constexpr bool PERM = true, AFTER_DRAIN = false, HAS_MID = false;
    float* SC; bf16_t* HS;
    __device__ __forceinline__ void operator()(const f32x4 (&acc)[2][2][4][2], const Unit& u, int wr, int wc, int fr, int fq) const {
        const int row0 = u.pm * BM + wr * 64 + fr, c8 = wc * 32 + 8 * fq;
        if (u.pn == 0) {
            PG8_FOR_AI_M { float* rp = SC + (size_t)(row0 + ai * HALF + m * 16) * 256 + c8;
#pragma unroll
                for (int bj = 0; bj < 2; ++bj)
#pragma unroll
                    for (int n = 0; n < 2; ++n) *(f32x4*)(rp + bj * HALF + 4 * n) = act4<3>(acc[ai][bj][m][n], 1.f); }
        } else {
            PG8_FOR_AI_M { bf16_t* rp = HS + (size_t)(row0 + ai * HALF + m * 16) * 256 + (u.pn - 1) * HALF + c8;
                *(u32x4*)rp = pack8(act4<2>(acc[ai][0][m][0], 1.f) * acc[ai][1][m][0], act4<2>(acc[ai][0][m][1], 1.f) * acc[ai][1][m][1]); }
        }
    }
};
template <int ldc> struct EpiPlain {
    static constexpr bool PERM = true, AFTER_DRAIN = false, HAS_MID = false;
    bf16_t* O;
    __device__ __forceinline__ void operator()(const f32x4 (&acc)[2][2][4][2], const Unit& u, int wr, int wc, int fr, int fq) const {
        const int row0 = u.pm * BM + wr * 64 + fr, col0 = u.pn * BM + wc * 32 + 8 * fq;
        PG8_FOR_AI_M { bf16_t* rowp = O + (size_t)(row0 + ai * HALF + m * 16) * ldc + col0;
#pragma unroll
            for (int bj = 0; bj < 2; ++bj) *(u32x4*)(rowp + bj * HALF) = pack8(acc[ai][bj][m][0], acc[ai][bj][m][1]); }
    }
};

template <class Epi, class Sched, bool ALIGN_EPI = false, bool SP2 = false>
__device__ __forceinline__ void gemm_phase(PG8_LAS unsigned char* lds, const Gemm g, const Sched& S, const Epi& E, const int wid) {
    const int lane = lane_id_asm(), tid = wid * 64 + lane, wr = wid >> 2, wc = wid & 3, fr = lane & 15, fq = lane >> 4;
    int K = g.K; asm volatile("" : "+s"(K));
    const int nt = K / BK;
    unsigned voffA[2], voffB[2];
#pragma unroll
    for (int i = 0; i < 2; ++i) { int R, C; stage_rc(tid * 16 + i * 8192, R, C); const int Rb = Epi::PERM ? ((R & ~31) + perm32(R & 31)) : R;
        voffA[i] = (unsigned)(R * g.lda + C) * 2u; voffB[i] = (unsigned)(Rb * g.ldb + C) * 2u; }
    const size_t kstep = (size_t)(BK * 2);
    const size_t hstepA = (size_t)HALF * g.lda * 2, hstepB = (size_t)HALF * g.ldb * 2;
    const size_t tstepA = 2 * hstepA, tstepB = 2 * hstepB;
    const unsigned ldsw = (unsigned)wid * 1024u;
    const int aoff = lds_byte(wr * 64 + fr, fq * 8), boff = lds_byte(wc * 32 + fr, fq * 8);
#define PG8_SA(b, h) (((b) * 2 + (h)) * HTB)
#define PG8_SB(b, h) ((4 + (b) * 2 + (h)) * HTB)
#define PG8_STAGE(bufoff, gbase, voff) do { _Pragma("unroll") for (int _i = 0; _i < 2; ++_i) \
        __builtin_amdgcn_global_load_lds((const unsigned*)((const char*)(gbase) + (voff)[_i]), (PG8_LAS unsigned*)(lds + (bufoff) + ldsw + _i * 8192), 16, 0, 0); } while (0)
#define PG8_LDA(dst, b, h) do { _Pragma("unroll") for (int m = 0; m < 4; ++m) _Pragma("unroll") for (int k = 0; k < 2; ++k) dst[m][k] = *(const PG8_LAS bf16x8*)(lds + PG8_SA(b, h) + aoff + m * 2048 + k * 1024); } while (0)
#define PG8_LDB(dst, b, h) do { _Pragma("unroll") for (int n = 0; n < 2; ++n) _Pragma("unroll") for (int k = 0; k < 2; ++k) dst[n][k] = *(const PG8_LAS bf16x8*)(lds + PG8_SB(b, h) + boff + n * 2048 + k * 1024); } while (0)
#define PG8_MMA(ai, bj, At, Bt) do { __builtin_amdgcn_s_setprio(1); _Pragma("unroll") for (int m = 0; m < 4; ++m) _Pragma("unroll") for (int n = 0; n < 2; ++n) _Pragma("unroll") for (int k = 0; k < 2; ++k) \
        acc[ai][bj][m][n] = __builtin_amdgcn_mfma_f32_16x16x32_bf16(Bt[n][k], At[m][k], acc[ai][bj][m][n], 0, 0, 0); __builtin_amdgcn_s_setprio(0); } while (0)
#define PG8_WAIT_V(n) asm volatile("s_waitcnt vmcnt(" #n ")" ::: "memory")
#define PG8_WAIT_L(n) asm volatile("s_waitcnt lgkmcnt(" #n ")" ::: "memory")
#define PG8_BAR __builtin_amdgcn_s_barrier()
#define PG8_SCHED __builtin_amdgcn_sched_barrier(0)
    Unit cur, nxt; int ui = 0;
    if (!S.next(0, cur)) return;
    f32x4 acc[2][2][4][2];
#pragma unroll
    for (int a = 0; a < 2; ++a)
#pragma unroll
        for (int b = 0; b < 2; ++b)
#pragma unroll
            for (int m = 0; m < 4; ++m)
#pragma unroll
                for (int n = 0; n < 2; ++n) acc[a][b][m][n] = (f32x4){0.f, 0.f, 0.f, 0.f};
    bf16x8 At[4][2], B0[2][2], B1[2][2];
    const char* cA = (const char*)g.A + (size_t)cur.pm * tstepA; const char* cB = (const char*)g.Bt + (size_t)cur.pn * tstepB;
    S.a_ready(cur);
    if constexpr (SP2) {
        PG8_STAGE(PG8_SB(0, 0), cB, voffB); PG8_STAGE(PG8_SB(0, 1), cB + hstepB, voffB); PG8_STAGE(PG8_SA(0, 0), cA, voffA); PG8_STAGE(PG8_SA(0, 1), cA + hstepA, voffA);
        if (wr == 1) PG8_BAR;
        PG8_WAIT_V(2); PG8_BAR;
        PG8_STAGE(PG8_SB(1, 0), cB + kstep, voffB); PG8_STAGE(PG8_SA(1, 0), cA + kstep, voffA); PG8_STAGE(PG8_SB(1, 1), cB + hstepB + kstep, voffB);
        PG8_WAIT_V(6); PG8_BAR;
    } else {
        PG8_STAGE(PG8_SB(0, 0), cB, voffB); PG8_STAGE(PG8_SA(0, 0), cA, voffA); PG8_STAGE(PG8_SB(0, 1), cB + hstepB, voffB); PG8_STAGE(PG8_SA(0, 1), cA + hstepA, voffA);
        if (wr == 1) PG8_BAR;
        PG8_WAIT_V(4); PG8_BAR;
        PG8_STAGE(PG8_SB(1, 0), cB + kstep, voffB); PG8_STAGE(PG8_SA(1, 0), cA + kstep, voffA); PG8_STAGE(PG8_SB(1, 1), cB + hstepB + kstep, voffB);
        PG8_WAIT_V(6); PG8_BAR;
    }
    for (;;) {
        const bool has_next = S.next(ui + 1, nxt);
        const char* nA = has_next ? (const char*)g.A + (size_t)nxt.pm * tstepA : cA; const char* nB = has_next ? (const char*)g.Bt + (size_t)nxt.pn * tstepB : cB;
        for (int t = 0; t < nt; t += 2) {
            const bool last = (t == nt - 2);
            const char* a1 = cA + (size_t)(t + 1) * kstep;
            const char* a2 = last ? nA : cA + (size_t)(t + 2) * kstep; const char* b2 = last ? nB : cB + (size_t)(t + 2) * kstep;
            const char* a3 = a2 + kstep; const char* b3 = b2 + kstep;
            if (last && has_next) S.a_ready(nxt);
            if constexpr (SP2) {
            PG8_LDB(B0, 0, 0); PG8_LDB(B1, 0, 1); PG8_SCHED; PG8_LDA(At, 0, 0); PG8_STAGE(PG8_SA(1, 1), a1 + hstepA, voffA);
            PG8_WAIT_V(8); PG8_WAIT_L(0); PG8_BAR; PG8_MMA(0, 0, At, B0); PG8_MMA(0, 1, At, B1); PG8_BAR; PG8_SCHED;
            PG8_LDA(At, 0, 1); PG8_STAGE(PG8_SB(0, 0), b2, voffB); PG8_STAGE(PG8_SB(0, 1), b2 + hstepB, voffB); PG8_STAGE(PG8_SA(0, 0), a2, voffA);
            PG8_WAIT_V(8); PG8_WAIT_L(0); PG8_BAR; PG8_MMA(1, 0, At, B0); PG8_MMA(1, 1, At, B1); PG8_BAR; PG8_SCHED;
            PG8_LDB(B0, 1, 0); PG8_LDB(B1, 1, 1); PG8_SCHED; PG8_LDA(At, 1, 0); PG8_STAGE(PG8_SA(0, 1), a2 + hstepA, voffA);
            PG8_WAIT_V(8); PG8_WAIT_L(0); PG8_BAR; PG8_MMA(0, 0, At, B0); PG8_MMA(0, 1, At, B1); PG8_BAR; PG8_SCHED;
            PG8_LDA(At, 1, 1); PG8_STAGE(PG8_SB(1, 0), b3, voffB); PG8_STAGE(PG8_SB(1, 1), b3 + hstepB, voffB); PG8_STAGE(PG8_SA(1, 0), a3, voffA);
            PG8_WAIT_V(8); PG8_WAIT_L(0); PG8_BAR; PG8_MMA(1, 0, At, B0); PG8_MMA(1, 1, At, B1); PG8_BAR; PG8_SCHED;
            } else {
            PG8_LDB(B0, 0, 0); PG8_SCHED; PG8_LDA(At, 0, 0); PG8_STAGE(PG8_SA(1, 1), a1 + hstepA, voffA);
            PG8_WAIT_L(8); PG8_BAR; PG8_WAIT_L(0); PG8_MMA(0, 0, At, B0); PG8_BAR; PG8_SCHED;
            PG8_LDB(B1, 0, 1); PG8_STAGE(PG8_SB(0, 0), b2, voffB);
            PG8_BAR; PG8_WAIT_L(0); PG8_MMA(0, 1, At, B1); PG8_BAR;
            PG8_LDA(At, 0, 1); PG8_STAGE(PG8_SA(0, 0), a2, voffA);
            PG8_BAR; PG8_WAIT_L(0); PG8_MMA(1, 0, At, B0); PG8_BAR; PG8_SCHED;
            PG8_STAGE(PG8_SB(0, 1), b2 + hstepB, voffB);
            PG8_WAIT_V(6); PG8_BAR; PG8_MMA(1, 1, At, B1); PG8_BAR;
            PG8_LDB(B0, 1, 0); PG8_SCHED; PG8_LDA(At, 1, 0); PG8_STAGE(PG8_SA(0, 1), a2 + hstepA, voffA);
            PG8_WAIT_L(8); PG8_BAR; PG8_WAIT_L(0); PG8_MMA(0, 0, At, B0); PG8_BAR; PG8_SCHED;
            PG8_LDB(B1, 1, 1); PG8_STAGE(PG8_SB(1, 0), b3, voffB);
            PG8_BAR; PG8_WAIT_L(0); PG8_MMA(0, 1, At, B1); PG8_BAR;
            PG8_LDA(At, 1, 1); PG8_STAGE(PG8_SA(1, 0), a3, voffA);
            PG8_BAR; PG8_WAIT_L(0); PG8_MMA(1, 0, At, B0); PG8_BAR; PG8_SCHED;
            PG8_STAGE(PG8_SB(1, 1), b3 + hstepB, voffB);
            PG8_WAIT_V(6); PG8_BAR; PG8_MMA(1, 1, At, B1); PG8_BAR;
            }
            if constexpr (Epi::HAS_MID) { if (t + 2 == E.mid_tiles) E.mid(acc, cur, wr, wc, fr, fq); }
        }
        if constexpr (ALIGN_EPI) { if (wr == 0) PG8_BAR; }
        if constexpr (!Epi::AFTER_DRAIN) { E(acc, cur, wr, wc, fr, fq); S.done(cur); }
        if (!has_next) break;
#pragma unroll
        for (int a = 0; a < 2; ++a)
#pragma unroll
            for (int b = 0; b < 2; ++b)
#pragma unroll
                for (int m = 0; m < 4; ++m)
#pragma unroll
                    for (int n = 0; n < 2; ++n) acc[a][b][m][n] = (f32x4){0.f, 0.f, 0.f, 0.f};
        cur = nxt; cA = nA; cB = nB; ++ui;
        if constexpr (ALIGN_EPI) { if (wr == 1) PG8_BAR; }
    }
    PG8_WAIT_V(0);
    if constexpr (!ALIGN_EPI) { if (wr == 0) PG8_BAR; }
    PG8_BAR;
    if constexpr (Epi::AFTER_DRAIN) { E.fused(acc, cur, wr, wc, fr, fq, lds, wid, lane); S.done(cur); }
#undef PG8_SA
#undef PG8_SB
#undef PG8_STAGE
#undef PG8_LDA
#undef PG8_LDB
#undef PG8_MMA
#undef PG8_WAIT_V
#undef PG8_WAIT_L
#undef PG8_BAR
#undef PG8_SCHED
}
template <class Epi, class Sched>
__device__ __forceinline__ void gemm_moe(PG8_LAS unsigned char* lds, const Gemm g, const Sched& S, const Epi& E, const int wid) {
    const int lane = lane_id_asm(), wr = wid >> 2, wc = wid & 3, fr = lane & 15, fq = lane >> 4;
    int K = g.K; asm volatile("" : "+s"(K));
    const int nt = K / BK;
    int RA[2]; unsigned cA2[2];
#pragma unroll
    for (int i = 0; i < 2; ++i) { RA[i] = 8 * (wid + 8 * i) + (lane >> 3); cA2[i] = (unsigned)(((lane & 7) ^ ((RA[i] >> 1) & 7)) * 16); }
    const size_t kstep = (size_t)(BK * 2);
    const unsigned ldsw = (unsigned)wid * 1024u;
    const int ar0 = wr * 64 + fr, br0 = wc * 32 + fr;
    const int aoff0 = ar0 * 128 + ((fq ^ ((ar0 >> 1) & 7)) << 4), aoff1 = aoff0 ^ 64;
    const int boff0 = br0 * 128 + ((fq ^ ((br0 >> 1) & 7)) << 4), boff1 = boff0 ^ 64;
    const int cg = wid & 3, kh = wid >> 2, bi = lane & 7, brq = lane >> 3;
    const unsigned pitchB4 = (unsigned)g.ldb * 4u;
    const unsigned koffB = (unsigned)(32 * kh + 4 * brq) * pitchB4;
    const size_t kstepB = (size_t)BK * pitchB4;
    unsigned wdst[4];
    { const int brow = S.b_row(cg, bi), q = 8 * kh + brq;
#pragma unroll
      for (int d = 0; d < 4; ++d) { const int row = brow + d; wdst[d] = (unsigned)(row * 128 + (((q >> 1) ^ ((row >> 1) & 7)) << 4) + (q & 1) * 8); } }
    constexpr int ABUF = 2 * HTB, SBOFF = 3 * ABUF;
#define PG8_SB(b) (SBOFF + (b) * HTB)
#define PG8_STAGE(ldsoff, gbase, voff) do { _Pragma("unroll") for (int _i = 0; _i < 2; ++_i) \
        __builtin_amdgcn_global_load_lds((const unsigned*)((const char*)(gbase) + (voff)[_i]), (PG8_LAS unsigned*)(lds + (ldsoff) + ldsw + _i * 8192), 16, 0, 0); } while (0)
#define PG8_LDA(dst, ldsoff) do { _Pragma("unroll") for (int m = 0; m < 4; ++m) { dst[m][0] = *(const PG8_LAS bf16x8*)(lds + (ldsoff) + aoff0 + m * 2048); dst[m][1] = *(const PG8_LAS bf16x8*)(lds + (ldsoff) + aoff1 + m * 2048); } } while (0)
#define PG8_LDB(dst, b) do { _Pragma("unroll") for (int n = 0; n < 2; ++n) { dst[n][0] = *(const PG8_LAS bf16x8*)(lds + PG8_SB(b) + boff0 + n * 2048); dst[n][1] = *(const PG8_LAS bf16x8*)(lds + PG8_SB(b) + boff1 + n * 2048); } } while (0)
#define PG8_MMA(ai) do { __builtin_amdgcn_s_setprio(1); _Pragma("unroll") for (int m = 0; m < 4; ++m) _Pragma("unroll") for (int n = 0; n < 2; ++n) _Pragma("unroll") for (int k = 0; k < 2; ++k) \
        acc[ai][m][n] = __builtin_amdgcn_mfma_f32_16x16x32_bf16(B0[n][k], At[m][k], acc[ai][m][n], 0, 0, 0); __builtin_amdgcn_s_setprio(0); } while (0)
#define PG8_BLOAD(braw, base) do { const char* p_ = (const char*)(base) + koffB; _Pragma("unroll") for (int j_ = 0; j_ < 4; ++j_) { const char* q_ = p_ + (size_t)j_ * pitchB4; \
        asm volatile("global_load_dwordx4 %0, %1, off" : "=v"(braw[j_]) : "v"(q_) : "memory"); } } while (0)
#define PG8_BWRITE(braw, b) do { _Pragma("unroll") for (int d_ = 0; d_ < 4; ++d_) { u32x2 w_; w_.x = cvt_pk_bf16(braw[0][d_], braw[1][d_]); w_.y = cvt_pk_bf16(braw[2][d_], braw[3][d_]); \
        *(PG8_LAS u32x2*)(lds + PG8_SB(b) + wdst[d_]) = w_; } } while (0)
#define PG8_BPIN(braw) asm volatile("" : "+v"(braw[0]), "+v"(braw[1]), "+v"(braw[2]), "+v"(braw[3]))
#define PG8_WAIT_V(n) asm volatile("s_waitcnt vmcnt(" #n ")" ::: "memory")
#define PG8_WAIT_L(n) asm volatile("s_waitcnt lgkmcnt(" #n ")" ::: "memory")
#define PG8_BAR __builtin_amdgcn_s_barrier()
#define PG8_SCHED __builtin_amdgcn_sched_barrier(0)
#define PG8_ZERO_ACC do { _Pragma("unroll") for (int a = 0; a < 2; ++a) _Pragma("unroll") for (int m = 0; m < 4; ++m) _Pragma("unroll") for (int n = 0; n < 2; ++n) acc[a][m][n] = (f32x4){0.f, 0.f, 0.f, 0.f}; } while (0)
#define PG8_ROT3(x) ((x) == 2 * ABUF ? 0 : (x) + ABUF)
    typedef unsigned u32x2 __attribute__((ext_vector_type(2)));
    Unit cur, nxt; int ui = 0;
    if (!S.next(0, cur)) return;
    f32x4 acc[2][4][2];
    PG8_ZERO_ACC;
    bf16x8 At[4][2], B0[2][2];
    f32x4 brE[4], brO[4];
    unsigned vA0[2], vA1[2]; int iN0[2], iN1[2];
#pragma unroll
    for (int i = 0; i < 2; ++i) { vA0[i] = S.off_of(S.row_id(cur, RA[i])) + cA2[i]; vA1[i] = S.off_of(S.row_id(cur, HALF + RA[i])) + cA2[i]; }
    const char* const gA = (const char*)g.A; const char* cB = (const char*)S.b_ptr(cur, cg, bi);
    bool full = S.rows(cur) > HALF;
    PG8_STAGE(0, gA, vA0); PG8_STAGE(HTB, gA, vA1);
    PG8_BLOAD(brE, cB); PG8_BLOAD(brO, cB + kstepB); PG8_WAIT_V(0); PG8_SCHED; PG8_BPIN(brE); PG8_BPIN(brO); PG8_BWRITE(brE, 0); PG8_BWRITE(brO, 1);
    PG8_BLOAD(brE, cB + 2 * kstepB); PG8_STAGE(ABUF, gA + kstep, vA0); PG8_STAGE(ABUF + HTB, gA + kstep, vA1); PG8_BLOAD(brO, cB + 3 * kstepB);
    PG8_WAIT_L(0);
    if (wr == 1) PG8_BAR;
    PG8_BAR;
    PG8_BAR;
    int rd = 0, st = 2 * ABUF;
    for (;;) {
        const bool has_next = S.next(ui + 1, nxt);
        const char* nB = has_next ? (const char*)S.b_ptr(nxt, cg, bi) : cB;
        if (has_next) {
#pragma unroll
            for (int i = 0; i < 2; ++i) { iN0[i] = S.row_id(nxt, RA[i]); iN1[i] = S.row_id(nxt, HALF + RA[i]); } }
        for (int t = 0; t < nt; t += 2) {
            const bool last = (t == nt - 2);
            const char* a2 = last ? gA : gA + (size_t)(t + 2) * kstep;
            const char* a3 = a2 + kstep;
            const char* b4 = (t + 4 < nt) ? cB + (size_t)(t + 4) * kstepB : nB + (size_t)(t + 4 - nt) * kstepB;
            const char* b5 = (t + 5 < nt) ? cB + (size_t)(t + 5) * kstepB : nB + (size_t)(t + 5 - nt) * kstepB;
            unsigned vx0[2], vx1[2];
            if (last && has_next) { asm volatile("" : "+v"(iN0[0]), "+v"(iN0[1]), "+v"(iN1[0]), "+v"(iN1[1]));
                vx0[0] = S.off_of(iN0[0]) + cA2[0]; vx0[1] = S.off_of(iN0[1]) + cA2[1]; vx1[0] = S.off_of(iN1[0]) + cA2[0]; vx1[1] = S.off_of(iN1[1]) + cA2[1]; }
            else { vx0[0] = vA0[0]; vx0[1] = vA0[1]; vx1[0] = vA1[0]; vx1[1] = vA1[1]; }
            PG8_LDB(B0, 0); PG8_SCHED; PG8_LDA(At, rd); PG8_STAGE(st, a2, vx0);
            PG8_WAIT_V(10); PG8_WAIT_L(0); PG8_BAR; PG8_MMA(0); PG8_BAR; PG8_SCHED;
            PG8_LDA(At, rd + HTB); PG8_SCHED; PG8_BPIN(brE); PG8_BWRITE(brE, 0); PG8_STAGE(st + HTB, a2, vx1); PG8_BLOAD(brE, b4);
            PG8_WAIT_V(14); PG8_WAIT_L(0); PG8_BAR; if (full) PG8_MMA(1); PG8_BAR; PG8_SCHED;
            rd = PG8_ROT3(rd); st = PG8_ROT3(st);
            PG8_LDB(B0, 1); PG8_SCHED; PG8_LDA(At, rd); PG8_STAGE(st, a3, vx0);
            PG8_WAIT_V(10); PG8_WAIT_L(0); PG8_BAR; PG8_MMA(0); PG8_BAR; PG8_SCHED;
            PG8_LDA(At, rd + HTB); PG8_SCHED; PG8_BPIN(brO); PG8_BWRITE(brO, 1); PG8_STAGE(st + HTB, a3, vx1); PG8_BLOAD(brO, b5);
            PG8_WAIT_V(14); PG8_WAIT_L(0); PG8_BAR; if (full) PG8_MMA(1); PG8_BAR; PG8_SCHED;
            rd = PG8_ROT3(rd); st = PG8_ROT3(st);
        }
        if (wr == 0) PG8_BAR;
        E(acc, cur, wr, wc, fr, fq);
        if (!has_next) break;
        PG8_ZERO_ACC;
        cur = nxt; cB = nB; ++ui; full = S.rows(cur) > HALF;
        asm volatile("" : "+v"(iN0[0]), "+v"(iN0[1]), "+v"(iN1[0]), "+v"(iN1[1]));
#pragma unroll
        for (int i = 0; i < 2; ++i) { vA0[i] = S.off_of(iN0[i]) + cA2[i]; vA1[i] = S.off_of(iN1[i]) + cA2[i]; }
        if (wr == 1) PG8_BAR;
    }
    PG8_WAIT_V(0);
    PG8_BAR;
#undef PG8_SB
#undef PG8_STAGE
#undef PG8_LDA
#undef PG8_LDB
#undef PG8_MMA
#undef PG8_BLOAD
#undef PG8_BWRITE
#undef PG8_BPIN
#undef PG8_WAIT_V
#undef PG8_WAIT_L
#undef PG8_BAR
#undef PG8_SCHED
#undef PG8_ZERO_ACC
#undef PG8_ROT3
}
struct EpiMoeUp {
    bf16_t* HE;
    __device__ __forceinline__ void operator()(const f32x4 (&acc)[2][4][2], const Unit& u, int wr, int wc, int fr, int fq) const {
        const int row0 = u.pm * BM + wr * 64 + fr, c4 = (u.pn & 3) * 64 + wc * 16 + 4 * fq;
#pragma unroll
        for (int ai = 0; ai < 2; ++ai)
#pragma unroll
            for (int m = 0; m < 4; ++m) { const f32x4 hv = act4<2>(acc[ai][m][0], 1.f) * acc[ai][m][1]; v2u w; w.x = cvt_pk_bf16(hv[0], hv[1]); w.y = cvt_pk_bf16(hv[2], hv[3]);
                *(v2u*)(HE + (size_t)(row0 + ai * HALF + m * 16) * 256 + c4) = w; }
    }
};
struct EpiMoeDown {
    bf16_t* YS; const int* LTOK; const float* LW; const PG8_LAS int* tabStart; const PG8_LAS int* tabCnt;
    __device__ __forceinline__ void operator()(const f32x4 (&acc)[2][4][2], const Unit& u, int wr, int wc, int fr, int fq) const {
        const int e = u.pn >> 3, base = (u.pm - tabStart[e]) * BM, nvalid = tabCnt[e] - base, col0 = (u.pn & 7) * HALF + wc * 32 + 8 * fq;
#pragma unroll
        for (int ai = 0; ai < 2; ++ai)
#pragma unroll
            for (int m = 0; m < 4; ++m) { const int r = ai * HALF + wr * 64 + m * 16 + fr;
                if (r < nvalid) { const size_t idx = (size_t)e * CAP + base + r; const int id = LTOK[idx]; const float w = LW[idx];
                    *(u32x4*)(YS + (size_t)id * 1024 + col0) = pack8(acc[ai][m][0] * w, acc[ai][m][1] * w); } }
    }
};

}

#define XB_TMO      128
#define XB_XCNT(j)  (256  + 64 * (j))
#define XB_XSUB(j)  (1280 + 64 * (j))
#define XB_XGEN(j)  (2304 + 64 * (j))
#define XB_TOP      3328
#define XB_TOPGEN   3392
#define XCD_BAR_WORDS 3456
#define XB_SPIN_CAP (1u << 18)

__device__ __forceinline__ unsigned xb_ld(unsigned* p)              { return __hip_atomic_load(p, __ATOMIC_RELAXED, __HIP_MEMORY_SCOPE_AGENT); }
__device__ __forceinline__ unsigned xb_add(unsigned* p, unsigned v) { return __hip_atomic_fetch_add(p, v, __ATOMIC_RELAXED, __HIP_MEMORY_SCOPE_AGENT); }
__device__ __forceinline__ unsigned xb_xcc_id() { return (unsigned)__builtin_amdgcn_s_getreg((3 << 11) | 20) & 0xFu; }
#define XB_SPIN(cond, bar) do { unsigned _sp = 0; while (cond) { __builtin_amdgcn_s_sleep(1); \
    if ((++_sp & 255u) == 0u) { if (xb_ld(&(bar)[XB_TMO])) break; if (_sp > XB_SPIN_CAP) { atomicAdd(&(bar)[XB_TMO], 1u); break; } } } } while (0)

struct XcdBarrier {
    unsigned* bar; unsigned x;
    volatile LAS unsigned* st;
};

__device__ __forceinline__ XcdBarrier xcd_barrier_post(unsigned* bar, volatile LAS unsigned* st) {
    XcdBarrier b; b.bar = bar; b.x = xb_xcc_id(); b.st = st;
    if (threadIdx.x == 0) (void)xb_add(&bar[XB_XCNT(b.x)], 1u);
    return b;
}
__device__ __forceinline__ void xcd_barrier_complete(unsigned* bar, unsigned x, unsigned& nloc, unsigned& nx) {
    const unsigned G = gridDim.x * gridDim.y * gridDim.z;
    unsigned sum, cnt, mine, sp = 0u;
    for (;;) {
        sum = 0u; cnt = 0u; mine = 0u;
#pragma unroll
        for (unsigned j = 0; j < 16; ++j) { const unsigned c = xb_ld(&bar[XB_XCNT(j)]); sum += c; cnt += (c > 0u) ? 1u : 0u; mine = (j == x) ? c : mine; }
        if (sum == G) break;
        __builtin_amdgcn_s_sleep(1);
        if ((++sp & 255u) == 0u) { if (xb_ld(&bar[XB_TMO])) break; if (sp > XB_SPIN_CAP) { atomicAdd(&bar[XB_TMO], 1u); break; } }
    }
    nloc = mine > 0u ? mine : 1u; nx = cnt > 0u ? cnt : 1u;
}

__device__ __forceinline__ void xcd_barrier(const XcdBarrier& b, const int wave) {
    asm volatile("s_waitcnt vmcnt(0)" ::: "memory");
    __syncthreads();
    if (wave == 0 && lane_id_asm() == 0) {
        unsigned* bar = b.bar;
        __builtin_amdgcn_s_waitcnt(0);
        unsigned nloc = b.st[0], nx = b.st[1];
        if (nloc == 0u) { xcd_barrier_complete(bar, b.x, nloc, nx); b.st[0] = nloc; b.st[1] = nx; }
        const unsigned old = xb_add(&bar[XB_XSUB(b.x)], 1u);
        const unsigned gen = old / nloc;
        if (old + 1u == (gen + 1u) * nloc) {
            __builtin_amdgcn_fence(__ATOMIC_RELEASE, "agent");
            asm volatile("s_waitcnt vmcnt(0)" ::: "memory");
            const unsigned og = xb_add(&bar[XB_TOP], 1u);
            const unsigned tg = og / nx;
            if (og + 1u == (tg + 1u) * nx) xb_add(&bar[XB_TOPGEN], 1u);
            else XB_SPIN(xb_ld(&bar[XB_TOPGEN]) == tg, bar);
            __builtin_amdgcn_fence(__ATOMIC_ACQUIRE, "agent");
            xb_add(&bar[XB_XGEN(b.x)], 1u);
            asm volatile("s_waitcnt vmcnt(0)" ::: "memory");
        } else {
            XB_SPIN(xb_ld(&bar[XB_XGEN(b.x)]) == gen, bar);
            __builtin_amdgcn_fence(__ATOMIC_ACQUIRE, "agent");
            asm volatile("s_waitcnt vmcnt(0)" ::: "memory");
        }
    }
    __syncthreads();
}

#include <hip/hip_bf16.h>
#include <cmath>
namespace attn_body {
using bf16=__hip_bfloat16;
using bf16x8=__attribute__((ext_vector_type(8)))short;
using s16x4=__attribute__((ext_vector_type(4)))short;
using f32x16=__attribute__((ext_vector_type(16)))float;
using f32x4v=__attribute__((ext_vector_type(4)))float;
using u32x4=__attribute__((ext_vector_type(4)))unsigned;
constexpr int BATCH=4,NHEAD=8,SEQ=4096,D=64,DM=NHEAD*D,OPITCH=1536;
constexpr int NW=8,QBLK=32,QB=QBLK*NW,KVBLK=64,NQB=SEQ/QB;
constexpr int ATTN_PITCH=DM, ATTN_UNIT_ROWS=QB;
__device__ __forceinline__ int crow(int r,int hi){return (r&3)+8*(r>>2)+4*hi;}
#define SBAR() __builtin_amdgcn_sched_barrier(0)
__device__ __forceinline__ void cmask(f32x16&p0,f32x16&p1,int jb,int qrel,int hi){
  const float NEG=-INFINITY; int kb=64*jb+4*hi;
  #pragma unroll
  for(int r=0;r<16;++r){int kv=kb+(r&3)+8*(r>>2); if(kv>qrel)p0[r]=NEG; if(kv+32>qrel)p1[r]=NEG;}
}

constexpr int NSLOT=3, SLOTB=8192;
constexpr int LDS_K=0, LDS_V=NSLOT*SLOTB, LDS_WS=2*NSLOT*SLOTB, LDS_OST=LDS_WS+NW*64*4, LDS_F=LDS_OST+NW*4096, LDS_BYTES=LDS_F+SEQ*4;
constexpr float C2=0.125f*1.4426950408889634f;
__device__ __forceinline__ void glds16(const void*gsrc,unsigned lds_dst){unsigned keep;
  asm volatile("s_mov_b32 %0, m0\n\ts_mov_b32 m0, %2\n\ts_nop 0\n\tglobal_load_lds_dwordx4 %1, off\n\ts_mov_b32 m0, %0":"=&s"(keep):"v"(gsrc),"s"(lds_dst):"memory");}
__device__ __forceinline__ float max3f(float a,float b,float c){float r;asm("v_max3_f32 %0, %1, %2, %3":"=v"(r):"v"(a),"v"(b),"v"(c));return r;}
__device__ __forceinline__ float max2f(float a,float b){float r;asm("v_max_f32_e32 %0, %1, %2":"=v"(r):"v"(a),"v"(b));return r;}
__device__ __forceinline__ float fadd_s(float a,float b){float r;asm("v_add_f32_e32 %0, %1, %2":"=v"(r):"v"(a),"v"(b));return r;}
__device__ __forceinline__ float fsub_s(float a,float b){float r;asm("v_sub_f32_e32 %0, %1, %2":"=v"(r):"v"(a),"v"(b));return r;}
typedef float f32x2_t __attribute__((ext_vector_type(2))); typedef __bf16 bf16x2_t __attribute__((ext_vector_type(2)));
__device__ __forceinline__ unsigned cvtpk_s(float lo,float hi){f32x2_t v={lo,hi};bf16x2_t b=__builtin_convertvector(v,bf16x2_t);return __builtin_bit_cast(unsigned,b);}
#define WAIT_BAR(N) asm volatile("s_waitcnt vmcnt(" #N ") lgkmcnt(0)\n\ts_barrier":::"memory")

__device__ __forceinline__ void qkt(f32x16&p0,f32x16&p1,const char*Kslot,const bf16x8*qr,int r32,int hi){
  const char*kb=Kslot+hi*1024+r32*16;
  #pragma unroll
  for(int d0=0;d0<4;++d0){
    const bf16x8 b0=*reinterpret_cast<const bf16x8*>(kb+d0*2048);
    const bf16x8 b1=*reinterpret_cast<const bf16x8*>(kb+d0*2048+512);
    p0=__builtin_amdgcn_mfma_f32_32x32x16_bf16(b0,qr[d0],p0,0,0,0);p1=__builtin_amdgcn_mfma_f32_32x32x16_bf16(b1,qr[d0],p1,0,0,0);}
}
typedef __attribute__((address_space(3))) const char* lds_cptr;
typedef short v4i16_t __attribute__((ext_vector_type(4)));
__device__ __forceinline__ void kload8(bf16x8*kf,lds_cptr kp){
  kf[0]=*(const __attribute__((address_space(3))) bf16x8*)(kp);      kf[1]=*(const __attribute__((address_space(3))) bf16x8*)(kp+512);
  kf[2]=*(const __attribute__((address_space(3))) bf16x8*)(kp+2048); kf[3]=*(const __attribute__((address_space(3))) bf16x8*)(kp+2560);
  kf[4]=*(const __attribute__((address_space(3))) bf16x8*)(kp+4096); kf[5]=*(const __attribute__((address_space(3))) bf16x8*)(kp+4608);
  kf[6]=*(const __attribute__((address_space(3))) bf16x8*)(kp+6144); kf[7]=*(const __attribute__((address_space(3))) bf16x8*)(kp+6656);
}
__device__ __forceinline__ void kload2(bf16x8*kf,lds_cptr kp,int j){ kf[2*j]=*(const __attribute__((address_space(3))) bf16x8*)(kp+j*2048); kf[2*j+1]=*(const __attribute__((address_space(3))) bf16x8*)(kp+j*2048+512); }
__device__ __forceinline__ s16x4 vtr(lds_cptr p){ return __builtin_bit_cast(s16x4,__builtin_amdgcn_ds_read_tr16_b64_v4i16((__attribute__((address_space(3))) v4i16_t*)p)); }
__device__ __forceinline__ float rowmax(const f32x16&p0,const f32x16&p1){
  float a=max3f(p0[0],p0[1],p1[0]),b=max3f(p0[2],p0[3],p1[1]);a=max3f(a,p1[2],p1[3]);
  #pragma unroll
  for(int r=4;r<16;r+=4){a=max3f(a,p0[r],p0[r+1]);b=max3f(b,p0[r+2],p0[r+3]);a=max3f(a,p1[r],p1[r+1]);b=max3f(b,p1[r+2],p1[r+3]);}
  const float m=max2f(a,b);
  auto rr=__builtin_amdgcn_permlane32_swap(__float_as_uint(m),__float_as_uint(m),false,false);
  return max2f(__uint_as_float(rr[0]),__uint_as_float(rr[1]));
}
__device__ __forceinline__ void pv(f32x16*o,int vb,bf16x8 pa0,bf16x8 pa1,bf16x8 pa2,bf16x8 pa3){
  #pragma unroll
  for(int d0=0;d0<2;++d0){s16x4 lo[4],hi[4];
    #pragma unroll
    for(int ks=0;ks<4;++ks){
      asm volatile("ds_read_b64_tr_b16 %0,%1 offset:%c2":"=&v"(lo[ks]):"v"(vb),"i"(d0*4096+ks*1024):"memory");
      asm volatile("ds_read_b64_tr_b16 %0,%1 offset:%c2":"=&v"(hi[ks]):"v"(vb),"i"(d0*4096+ks*1024+512):"memory");}
    asm volatile("s_waitcnt lgkmcnt(0)":::"memory");SBAR();
    #define PK(k) (bf16x8){lo[k][0],lo[k][1],lo[k][2],lo[k][3],hi[k][0],hi[k][1],hi[k][2],hi[k][3]}
    o[d0]=__builtin_amdgcn_mfma_f32_32x32x16_bf16(pa0,PK(0),o[d0],0,0,0);
    o[d0]=__builtin_amdgcn_mfma_f32_32x32x16_bf16(pa1,PK(1),o[d0],0,0,0);
    o[d0]=__builtin_amdgcn_mfma_f32_32x32x16_bf16(pa2,PK(2),o[d0],0,0,0);
    o[d0]=__builtin_amdgcn_mfma_f32_32x32x16_bf16(pa3,PK(3),o[d0],0,0,0);
    #undef PK
  }
}

#ifndef ATTN_STORE16
#define ATTN_STORE16(p,v) (*(u32x4*)(p)=(v))
#endif
template<int THRL> __device__ __forceinline__ void attn_unit(int b,int h,int qb,const bf16*Q,const bf16*__restrict__ K,const bf16*__restrict__ V,bf16*O,const float*__restrict__ F2bh,const unsigned*__restrict__ nrm,char*shm,const int wid){
  const int lane=lane_id_asm(),tid=wid*64+lane,r32=lane&31,hi=lane>>5;
  const long rowbase=(long)b*SEQ; const int q0=qb*QB;
  int j0;
  { const int NTf=(q0+QB)/KVBLK; const float sb=__builtin_sqrtf(__uint_as_float(nrm[b*NHEAD+h])*__uint_as_float(nrm[64+(b*NHEAD+h)*16+qb]));
    const float thr=F2bh[q0]+(2.0f*sb+40.0f); const bool neg=(lane<NTf-4)&&(F2bh[64*lane+63]>thr);
    j0=(int)__builtin_popcountll(__ballot(neg))&~1; j0=(int)__builtin_amdgcn_readfirstlane(j0); }
  const bf16*Qw=Q+(rowbase+q0+wid*QBLK)*DM+h*D;
  const bf16*Kh=K+(rowbase+(long)j0*KVBLK)*DM+h*D,*Vh=V+(rowbase+(long)j0*KVBLK)*DM+h*D;
  const unsigned lds0=(unsigned)(uintptr_t)shm;
  float*wsf=(float*)(shm+LDS_WS)+wid*64;
  const bf16*ksrc=Kh+(long)lane*DM+wid*8;
  const bf16*vsrc=Vh+(long)(16*(wid&3)+(lane>>2))*DM+(wid>>2)*32+(lane&3)*8;
  const unsigned kdst=lds0+LDS_K+wid*1024, vdst=lds0+LDS_V+wid*1024;
  #define DMA_K(t,slot) glds16(ksrc+(long)(t)*KVBLK*DM,(unsigned)__builtin_amdgcn_readfirstlane(kdst+(slot)))
  #define DMA_V(t,slot) glds16(vsrc+(long)(t)*KVBLK*DM,(unsigned)__builtin_amdgcn_readfirstlane(vdst+(slot)))
  const int vb0=(int)(lds0+LDS_V)+((lane>>4)&1)*32+(lane&3)*8+(4*hi+((lane&15)>>2))*64;
  const char*Kbase=shm+LDS_K; bf16x8 kf[8];
  const lds_cptr shm3=(lds_cptr)shm; const lds_cptr kp0=shm3+LDS_K+hi*1024+r32*16; const lds_cptr vp0=shm3+LDS_V+((lane>>4)&1)*32+(lane&3)*8+(4*hi+((lane&15)>>2))*64;
  const int NT=(q0+QB)/KVBLK-j0;
  typedef __attribute__((address_space(3))) f32x4v lds_f4; typedef __attribute__((address_space(3))) const f32x4v lds_cf4;
  { const int nk4=(q0+QB-j0*KVBLK)>>2; const f32x4v*src=(const f32x4v*)(F2bh+j0*KVBLK); lds_f4*dstF=(lds_f4*)((__attribute__((address_space(3))) char*)shm+LDS_F);
    for(int i=tid;i<nk4;i+=NW*64)dstF[i]=src[i]; }
  const float fq2=F2bh[q0+wid*QBLK+r32];
  lds_cf4*const fkp=(lds_cf4*)((__attribute__((address_space(3))) const char*)shm+LDS_F)+hi;
  #define FINIT(P,t,half) do{ lds_cf4*fp_=fkp+16*(t)+8*(half); const float base_=fq2-mhat; _Pragma("unroll") for(int g_=0;g_<4;++g_){ const f32x4v a_=fp_[2*g_]; \
      _Pragma("unroll") for(int e_=0;e_<4;++e_) P[4*g_+e_]=base_-a_[e_]; } }while(0)
  DMA_K(0,0);DMA_V(0,0);DMA_K(1,SLOTB);
  bf16x8 qr[4];
  #pragma unroll
  for(int d0=0;d0<4;++d0)qr[d0]=*reinterpret_cast<const bf16x8*>(&Qw[(long)r32*DM+d0*16+hi*8]);
  float mhat=0.f,l_reg=0.f;f32x16 o[2];o[0]=f32x16{};o[1]=f32x16{};
  const int qrel=wid*QBLK+r32;
  #define CMASK(P0,P1,t) do{int jb_=(t)-(NT-4); if(jb_>=0)cmask(P0,P1,jb_,qrel,hi);}while(0)
  bool resc=false;
  #define START(P0,P1) do{ const float rm=rowmax(P0,P1); resc=false; \
    { const float dl=rm; mhat=fadd_s(mhat,dl); \
      _Pragma("unroll") for(int r=0;r<16;++r){P0[r]=fsub_s(P0[r],dl);P1[r]=fsub_s(P1[r],dl);} \
      } \
    _Pragma("unroll") for(int r=0;r<16;++r)P0[r]=__builtin_amdgcn_exp2f(P0[r]); }while(0)
  #define RESC() do{ if(resc){ asm volatile("s_waitcnt lgkmcnt(0)":::"memory"); \
      _Pragma("unroll") for(int d_=0;d_<2;++d_) _Pragma("unroll") for(int r=0;r<16;++r)o[d_][r]*=wsf[crow(r,hi)]; } }while(0)
  f32x16 pA0,pA1,pB0,pB1;
  int sl_prev=0,sl_cur=0,sl_next=SLOTB;
  #define ROT() do{sl_prev=sl_cur;sl_cur=sl_next;sl_next=(sl_next==(NSLOT-1)*SLOTB)?0:sl_next+SLOTB;}while(0)
  DMA_K(2,2*SLOTB);
  WAIT_BAR(3);
  FINIT(pA0,0,0);FINIT(pA1,0,1);qkt(pA0,pA1,Kbase,qr,r32,hi);asm volatile("s_nop 15\n\ts_nop 7":"+v"(pA0),"+v"(pA1));CMASK(pA0,pA1,0);
  START(pA0,pA1);
  _Pragma("unroll") for(int r=0;r<16;++r)pA1[r]=__builtin_amdgcn_exp2f(pA1[r]);
  WAIT_BAR(0);
  DMA_K(3,0);DMA_V(1,SLOTB);
  ROT();
  kload8(kf,kp0+sl_cur);
  WAIT_BAR(2);
  s16x4 vlo[8],vhi[8]; u32x4 pw0,pw1,pw2,pw3;
  #define PKW(P,B) cvtpk_s(P[B],P[B+1])
  #define PAF(k) __builtin_bit_cast(bf16x8,pw##k)
  #define VFR(i) (bf16x8){vlo[i][0],vlo[i][1],vlo[i][2],vlo[i][3],vhi[i][0],vhi[i][1],vhi[i][2],vhi[i][3]}
  #define PIN(x) asm volatile("":"+v"(x))
  #define MX3(a,b,c) __builtin_fmaxf(__builtin_fmaxf((a),(b)),(c))
  #define GAPA(MF,A0,A1,A2,A3,W0,W1,PW) do{ MF; sacc+=A0; sacc+=A1; sacc+=A2; sacc+=A3; PIN(sacc); W0; W1; PIN(PW); SBAR(); }while(0)
  #define EX(v) __builtin_amdgcn_exp2f(v)
  #define GAPB(MF,X,B) do{ MF; X[B]=EX(X[B]); X[B+1]=EX(X[B+1]); X[B+2]=EX(X[B+2]); X[B+3]=EX(X[B+3]); PIN(X); SBAR(); }while(0)
  #define VRD(i) do{ vlo[i]=vtr(vp_+(((i)>>2)*4096+((i)&3)*1024)); vhi[i]=vtr(vp_+(((i)>>2)*4096+((i)&3)*1024+512)); }while(0)
  #define KRD(G,j) do{ if(G){ kload2(kf,kp0+sl_next,j); SBAR(); } }while(0)
  #define STEP(C0,C1,P0,P1,t,GK,GV,GL) do{ SBAR(); \
    const lds_cptr vp_=vp0+sl_prev; \
    FINIT(C0,t,0); SBAR(); VRD(0); SBAR(); float sacc=(P0[0]+P0[1]); \
    GAPA(C0=__builtin_amdgcn_mfma_f32_32x32x16_bf16(kf[0],qr[0],C0,0,0,0), P0[2],P0[3],P0[4],P0[5],     pw0[0]=PKW(P0,0), pw0[1]=PKW(P0,2), pw0); \
    FINIT(C1,t,1); SBAR(); VRD(4); SBAR(); GAPA(C1=__builtin_amdgcn_mfma_f32_32x32x16_bf16(kf[1],qr[0],C1,0,0,0), P0[6],P0[7],P0[8],P0[9],     pw0[2]=PKW(P0,4), pw0[3]=PKW(P0,6), pw0); \
    VRD(1); SBAR(); GAPA(C0=__builtin_amdgcn_mfma_f32_32x32x16_bf16(kf[2],qr[1],C0,0,0,0),   P0[10],P0[11],P0[12],P0[13], pw1[0]=PKW(P0,8), pw1[1]=PKW(P0,10), pw1); \
    VRD(5); SBAR(); GAPA(C1=__builtin_amdgcn_mfma_f32_32x32x16_bf16(kf[3],qr[1],C1,0,0,0),   P0[14],P0[15],P1[0],P1[1],   pw1[2]=PKW(P0,12),pw1[3]=PKW(P0,14), pw1); \
    VRD(2); SBAR(); GAPA(C0=__builtin_amdgcn_mfma_f32_32x32x16_bf16(kf[4],qr[2],C0,0,0,0),   P1[2],P1[3],P1[4],P1[5],     pw2[0]=PKW(P1,0), pw2[1]=PKW(P1,2), pw2); \
    VRD(6); SBAR(); GAPA(C1=__builtin_amdgcn_mfma_f32_32x32x16_bf16(kf[5],qr[2],C1,0,0,0),   P1[6],P1[7],P1[8],P1[9],     pw2[2]=PKW(P1,4), pw2[3]=PKW(P1,6), pw2); \
    VRD(3); SBAR(); GAPA(C0=__builtin_amdgcn_mfma_f32_32x32x16_bf16(kf[6],qr[3],C0,0,0,0),   P1[10],P1[11],P1[12],P1[13], pw3[0]=PKW(P1,8), pw3[1]=PKW(P1,10), pw3); \
    VRD(7); SBAR(); GAPA(C1=__builtin_amdgcn_mfma_f32_32x32x16_bf16(kf[7],qr[3],C1,0,0,0),   P1[14],P1[15],0.f,0.f,       pw3[2]=PKW(P1,12),pw3[3]=PKW(P1,14), pw3); \
    l_reg+=sacc; \
    if(GK){DMA_K((t)+3,sl_cur);} if(GV){DMA_V((t)+1,sl_next);} \
    CMASK(C0,C1,t); \
    { float a=MX3(C0[0],C0[1],C1[0]),b=MX3(C0[2],C0[3],C1[1]); a=MX3(a,C1[2],C1[3]); \
      _Pragma("unroll") for(int r=4;r<16;r+=4){a=MX3(a,C0[r],C0[r+1]);b=MX3(b,C0[r+2],C0[r+3]);a=MX3(a,C1[r],C1[r+1]);b=MX3(b,C1[r+2],C1[r+3]);} \
      float rm=__builtin_fmaxf(a,b); { auto rr=__builtin_amdgcn_permlane32_swap(__float_as_uint(rm),__float_as_uint(rm),false,false); rm=__builtin_fmaxf(__uint_as_float(rr[0]),__uint_as_float(rr[1])); } \
      resc=false; \
      if(__builtin_expect(__any(rm>(float)THRL),0)){ const float dl=__builtin_fmaxf(rm,0.f); mhat+=dl; \
        _Pragma("unroll") for(int r=0;r<16;++r){C0[r]-=dl;C1[r]-=dl;} \
        const float f=__builtin_amdgcn_exp2f(-dl); l_reg*=f; if(hi==0)wsf[r32]=f; resc=true; } } \
    SBAR(); \
    GAPB(o[0]=__builtin_amdgcn_mfma_f32_32x32x16_bf16(PAF(0),VFR(0),o[0],0,0,0), C0,0); \
    GAPB(o[1]=__builtin_amdgcn_mfma_f32_32x32x16_bf16(PAF(0),VFR(4),o[1],0,0,0), C0,4); \
    KRD(GL,0); GAPB(o[0]=__builtin_amdgcn_mfma_f32_32x32x16_bf16(PAF(1),VFR(1),o[0],0,0,0), C0,8); \
    KRD(GL,1); GAPB(o[1]=__builtin_amdgcn_mfma_f32_32x32x16_bf16(PAF(1),VFR(5),o[1],0,0,0), C0,12); \
    KRD(GL,2); GAPB(o[0]=__builtin_amdgcn_mfma_f32_32x32x16_bf16(PAF(2),VFR(2),o[0],0,0,0), C1,0); \
    KRD(GL,3); GAPB(o[1]=__builtin_amdgcn_mfma_f32_32x32x16_bf16(PAF(2),VFR(6),o[1],0,0,0), C1,4); \
    GAPB(o[0]=__builtin_amdgcn_mfma_f32_32x32x16_bf16(PAF(3),VFR(3),o[0],0,0,0), C1,8); \
    GAPB(o[1]=__builtin_amdgcn_mfma_f32_32x32x16_bf16(PAF(3),VFR(7),o[1],0,0,0), C1,12); \
    }while(0)
  int t=1;
  #undef CMASK
  #define CMASK(P0,P1,t) do{}while(0)
  for(;t+5<NT;t+=2){
    STEP(pB0,pB1,pA0,pA1,t,true,true,true);     WAIT_BAR(2); RESC(); ROT();
    STEP(pA0,pA1,pB0,pB1,t+1,true,true,true);   WAIT_BAR(2); RESC(); ROT();
  }
  #undef CMASK
  #define CMASK(P0,P1,t) do{int jb_=(t)-(NT-4); if(jb_>=0)cmask(P0,P1,jb_,qrel,hi);}while(0)
  #define ENDW(tt) do{ if((tt)+3<NT){WAIT_BAR(2);} else if((tt)+2<NT){WAIT_BAR(1);} else {WAIT_BAR(0);} }while(0)
  for(;t+1<NT;t+=2){
    STEP(pB0,pB1,pA0,pA1,t,(t+3<NT),(t+1<NT),(t+1<NT));       ENDW(t);   RESC(); ROT();
    STEP(pA0,pA1,pB0,pB1,t+1,(t+4<NT),(t+2<NT),(t+2<NT));     ENDW(t+1); RESC(); ROT();
  }
  STEP(pB0,pB1,pA0,pA1,NT-1,false,false,false); RESC();
  { float sacc=pB0[0]+pB0[1]; _Pragma("unroll") for(int r=2;r<16;++r)sacc+=pB0[r]; _Pragma("unroll") for(int r=0;r<16;++r)sacc+=pB1[r]; l_reg+=sacc;
    pw0=(u32x4){PKW(pB0,0),PKW(pB0,2),PKW(pB0,4),PKW(pB0,6)};pw1=(u32x4){PKW(pB0,8),PKW(pB0,10),PKW(pB0,12),PKW(pB0,14)};pw2=(u32x4){PKW(pB1,0),PKW(pB1,2),PKW(pB1,4),PKW(pB1,6)};pw3=(u32x4){PKW(pB1,8),PKW(pB1,10),PKW(pB1,12),PKW(pB1,14)};
    SBAR(); pv(o,vb0+sl_cur,PAF(0),PAF(1),PAF(2),PAF(3)); }
  #undef PKW
  #undef PAF
  #undef VFR
  #undef PIN
  #undef MX3
  #undef GAPA
  #undef GAPB
  #undef EX
  #undef VRD
  #undef KRD
  #undef STEP
  #undef ENDW
  {auto rr=__builtin_amdgcn_permlane32_swap(__float_as_uint(l_reg),__float_as_uint(l_reg),false,false);l_reg=__uint_as_float(rr[0])+__uint_as_float(rr[1]);}
  if(hi==0)wsf[32+r32]=l_reg;asm volatile("s_waitcnt lgkmcnt(0)":::"memory");
  float rli[16];
  #pragma unroll
  for(int r=0;r<16;++r)rli[r]=__builtin_amdgcn_rcpf(wsf[32+crow(r,hi)]);
  bf16*Ow=O+(rowbase+q0+wid*QBLK)*OPITCH+h*D;
  { bf16*stg=(bf16*)(shm+LDS_OST)+wid*2048;
    #pragma unroll
    for(int r=0;r<16;++r){const int orow=crow(r,hi);
      #pragma unroll
      for(int d0=0;d0<2;++d0)stg[orow*64+d0*32+r32]=__float2bfloat16(o[d0][r]*rli[r]);}
    asm volatile("s_waitcnt lgkmcnt(0)":::"memory");
    #pragma unroll
    for(int i=0;i<4;++i){const int row=i*8+(lane>>3),ch=lane&7; const u32x4 v=*(const u32x4*)(stg+row*64+ch*8); ATTN_STORE16(Ow+(long)row*OPITCH+ch*8,v);} }
  asm volatile("s_waitcnt lgkmcnt(0)\n\ts_barrier":::"memory");
  #undef FINIT
  #undef DMA_K
  #undef DMA_V
  #undef CMASK
  #undef START
  #undef RESC
  #undef ROT
}
constexpr int ATTN_LDS_BYTES=LDS_BYTES;
struct AttnTensors { const bf16* Q; const bf16* K; const bf16* V; bf16* O; const float* F2; const unsigned* nrm; };
struct AttnUnit { int bh; int qb; };
struct StaticOrder {
  int vcu;
  __device__ __forceinline__ explicit StaticOrder(int grid,int block):vcu((block%8)*(grid/8)+block/8){}
  __device__ __forceinline__ bool next(int i,AttnUnit&u)const{ if(i>=2)return false; const int s=vcu&7; u.bh=vcu>>3; u.qb=(i==0)?15-s:s; return true; }
  __device__ __forceinline__ void a_ready(const AttnUnit&)const{}
  __device__ __forceinline__ void done(const AttnUnit&)const{}
};
template<int THRL=8> __device__ __forceinline__ void attn_phase_queue(char*lds,const AttnTensors&T,unsigned*qhead,volatile __attribute__((address_space(3))) unsigned*slot,const int wid){
  for(;;){
    if(wid==0&&lane_id_asm()==0)*slot=__hip_atomic_fetch_add(qhead,1u,__ATOMIC_RELAXED,__HIP_MEMORY_SCOPE_AGENT);
    __syncthreads();
    const unsigned u=*slot;
    if(u>=(unsigned)(BATCH*NHEAD*NQB))break;
    const int qb=NQB-1-(int)(u>>5),bh=(int)(u&31u);
    attn_unit<THRL>(bh/NHEAD,bh%NHEAD,qb,T.Q,T.K,T.V,T.O,T.F2+(long)bh*SEQ,T.nrm,lds,wid);
  }
}
template<class Sched,int THRL=8> __device__ __forceinline__ void attn_phase(char*lds,const AttnTensors&T,const Sched&S,const int wid){
  AttnUnit u;
  for(int i=0;S.next(i,u);++i){ S.a_ready(u); attn_unit<THRL>(u.bh/NHEAD,u.bh%NHEAD,u.qb,T.Q,T.K,T.V,T.O,T.F2+(long)u.bh*SEQ,T.nrm,lds,wid); S.done(u); }
}
#undef SBAR
#undef WAIT_BAR
}

struct Args {
    const float* in[21]; float* out; unsigned char* ws; int ph_lo, ph_hi; int use_bar, bar_region;
};
struct Frame {
    LAS unsigned char* lds; volatile LAS unsigned* MISC; unsigned* ctl;
    int wave, vcu, G;
};

__device__ __forceinline__ void tr_item(const float* __restrict__ W, int sld, int scol, int nvalid, int k0, bf16_t* __restrict__ dst, int dld, int drow0, int dcol, LAS float* scr, int lane) {
    const int c = lane & 31;
#pragma unroll 8
    for (int i = 0; i < 32; ++i) { const int kk = 2 * i + (lane >> 5); scr[kk * 33 + c] = (c < nvalid) ? W[(size_t)(k0 + kk) * sld + scol + c] : 0.f; }
    LDS_WAIT(); asm volatile("" ::: "memory");
    const int c8 = lane & 7;
#pragma unroll
    for (int j = 0; j < 4; ++j) { const int n = (lane >> 3) + 8 * j; const LAS float* s = scr + (8 * c8) * 33 + n;
        v4u o; o.x = cvt_pk_bf16(s[0 * 33], s[1 * 33]); o.y = cvt_pk_bf16(s[2 * 33], s[3 * 33]); o.z = cvt_pk_bf16(s[4 * 33], s[5 * 33]); o.w = cvt_pk_bf16(s[6 * 33], s[7 * 33]);
        if (n < nvalid) *(v4u*)(dst + (size_t)(drow0 + n) * dld + dcol + k0 + 8 * c8) = o; }
    LDS_WAIT(); asm volatile("" ::: "memory");
}
__device__ __forceinline__ int gu_row(int n, int which, int g) { return 2 * g * (n / g) + which * g + (n % g); }
__device__ __forceinline__ int rope_row(int n) {
    const int which = n >> 9, c = n & 511, tile = c >> 8, cc = c & 255, hl = cc >> 6, d = cc & 63;
    return which * 512 + tile * 256 + 128 * (d >> 5) + 32 * hl + (d & 31);
}

__device__ __forceinline__ void p0_prologue(const Args& a, Frame& F) {
    unsigned char* ws = a.ws; const int lane_ = lane_id_asm(), tid_ = F.wave * 64 + lane_;
    {
        LAS float* sc = (LAS float*)(F.lds);
        LAS float* part = (LAS float*)(F.lds + 16384);
        float* MOD = (float*)(ws + WS_MOD); const float* c = a.in[1]; const float* w_ada = a.in[2]; const float* b_ada = a.in[3];
        for (int it = blockIdx.x; it < 96; it += F.G) {
            for (int i = tid_; i < 4096; i += 512) { const float cv = c[i]; sc[i] = cv / (1.0f + expf(-cv)); }
            __syncthreads();
            const int col = it * 64 + lane_; float acc0 = 0.f, acc1 = 0.f, acc2 = 0.f, acc3 = 0.f;
            for (int d = F.wave * 128; d < F.wave * 128 + 128; ++d) { const float w = w_ada[(size_t)d * 6144 + col]; acc0 += sc[d] * w; acc1 += sc[1024 + d] * w; acc2 += sc[2048 + d] * w; acc3 += sc[3072 + d] * w; }
            part[(F.wave * 4 + 0) * 64 + lane_] = acc0; part[(F.wave * 4 + 1) * 64 + lane_] = acc1; part[(F.wave * 4 + 2) * 64 + lane_] = acc2; part[(F.wave * 4 + 3) * 64 + lane_] = acc3;
            __syncthreads();
            if (tid_ < 256) { const int b = tid_ >> 6, l = tid_ & 63; float s = 0.f;
#pragma unroll
                for (int w = 0; w < 8; ++w) s += part[(w * 4 + b) * 64 + l];
                MOD[b * 6144 + it * 64 + l] = s + b_ada[it * 64 + l]; }
            __syncthreads();
        }
    }
    { float* COS = (float*)(ws + WS_COS); float* SIN = (float*)(ws + WS_SIN);
      for (int idx = blockIdx.x * 512 + tid_; idx < S_ * 32; idx += F.G * 512) { const int pos = idx >> 5, i = idx & 31;
          const float inv = exp2f(-(float)i * (13.287712379549449f / 32.0f)); const float ang = (float)pos * inv; float s, c; sincos_cw(ang, s, c); COS[idx] = c; SIN[idx] = s; } }
    LAS float* scr = (LAS float*)(F.lds + 32768 + F.wave * 8704);
    bf16_t* WIN = (bf16_t*)(ws + WS_WIN); bf16_t* WAB = (bf16_t*)(ws + WS_WAB); bf16_t* WO = (bf16_t*)(ws + WS_WO); bf16_t* WRS = (bf16_t*)(ws + WS_WRS); bf16_t* WSD = (bf16_t*)(ws + WS_WSD);
    bf16_t* WEG = (bf16_t*)(ws + WS_WEG); bf16_t* WED = (bf16_t*)(ws + WS_WED);
    const float* w_in = a.in[5];
    constexpr int J0 = 16 * 48, J1 = 16 * 32, J2 = 16 * 128, J3 = 16, J4 = 8 * 32, J5 = 16 * 32, J6 = 16 * 32, J7 = 16 * 8, J8 = 16 * 8, J9 = 16 * 8, J10 = 4 * 32;
    constexpr int JS = J0 + J1 + J2 + J3 + J4 + J5 + J6 + J7 + J8 + J9 + J10, NITEMS = JS;
    const int gw = F.vcu * NWAVES + F.wave, NGW = F.G * NWAVES, lane = lane_;
    for (int it = gw; it < NITEMS; it += NGW) {
        int r = it;
        if (r < J0) { const int kb = r / 48, nb = r % 48; tr_item(w_in, 6664, nb * 32, 32, kb * 64, WIN, 1024, nb * 32, 0, scr, lane); continue; } r -= J0;
        if (r < J1) { const int kb = r / 32, nb = r % 32; tr_item(w_in, 6664, 1544 + nb * 32, 32, kb * 64, WIN, 1024, 1536 + rope_row(nb * 32), 0, scr, lane); continue; } r -= J1;
        if (r < J2) { const int kb = r / 128, nb = r % 128; tr_item(w_in, 6664, 2568 + nb * 32, 32, kb * 64, WIN, 1024, 2560 + nb * 32, 0, scr, lane); continue; } r -= J2;
        if (r < J3) { tr_item(w_in, 6664, 1536, 8, r * 64, WIN, 1024, 6656, 0, scr, lane); continue; } r -= J3;
        if (r < J4) { const int kb = r / 32, nb = r % 32; tr_item(a.in[8], 1024, nb * 32, 32, kb * 64, WAB, 1536, nb * 32, 0, scr, lane); continue; } r -= J4;
        if (r < J5) { const int kb = r / 32, nb = r % 32; tr_item(a.in[9], 1024, nb * 32, 32, kb * 64, WAB, 1536, nb * 32, 512, scr, lane); continue; } r -= J5;
        if (r < J6) { const int kb = r / 32, nb = r % 32; tr_item(a.in[10], 1024, nb * 32, 32, kb * 64, WO, 1024, nb * 32, 0, scr, lane); continue; } r -= J6;
        if (r < J7) { const int kb = r / 8, nb = r % 8; tr_item(a.in[12], 256, nb * 32, 32, kb * 64, WRS, 1024, nb * 32, 0, scr, lane); continue; } r -= J7;
        if (r < J8) { const int kb = r / 8, nb = r % 8; tr_item(a.in[17], 256, nb * 32, 32, kb * 64, WRS, 1024, 256 + gu_row(nb * 32, 0, GU_G_SH), 0, scr, lane); continue; } r -= J8;
        if (r < J9) { const int kb = r / 8, nb = r % 8; tr_item(a.in[18], 256, nb * 32, 32, kb * 64, WRS, 1024, 256 + gu_row(nb * 32, 1, GU_G_SH), 0, scr, lane); continue; } r -= J9;
        { const int kb = r / 32, nb = r % 32; tr_item(a.in[19], 1024, nb * 32, 32, kb * 64, WSD, 256, nb * 32, 0, scr, lane); }
    }
}

__device__ __forceinline__ void norm_mod_rows(const Frame& F, const float* __restrict__ src, const float* __restrict__ g, const float* __restrict__ mod, int shift_off, int scale_off, bf16_t* __restrict__ dst) {
    const int gw = F.vcu * NWAVES + F.wave, NGW = F.G * NWAVES, lane = lane_id_asm();
    f32x4 gv[4];
#pragma unroll
    for (int j = 0; j < 4; ++j) gv[j] = *((const f32x4*)g + lane + 64 * j);
    for (int row = gw; row < T_; row += NGW) {
        const f32x4* xr = (const f32x4*)(src + (size_t)row * D_) + lane; f32x4 v[4]; float s = 0.f;
#pragma unroll
        for (int j = 0; j < 4; ++j) { v[j] = xr[64 * j]; s += (v[j].x * v[j].x + v[j].y * v[j].y) + (v[j].z * v[j].z + v[j].w * v[j].w); }
        const float r = rsqrtf(wave_sum(s) * (1.f / D_) + EPS);
        const float* mb = mod + (row / S_) * 6144; v2u* o8 = (v2u*)(dst + (size_t)row * D_) + lane;
#pragma unroll
        for (int j = 0; j < 4; ++j) { const f32x4 sc = *((const f32x4*)(mb + scale_off) + lane + 64 * j), sh = *((const f32x4*)(mb + shift_off) + lane + 64 * j);
            const f32x4 y = (v[j] * r) * gv[j] * (sc + 1.0f) + sh; v2u w; w.x = cvt_pk_bf16(y[0], y[1]); w.y = cvt_pk_bf16(y[2], y[3]); o8[64 * j] = w; }
    }
}

__device__ __forceinline__ void qk_norm_phase(const Frame& F, const bf16_t* __restrict__ QF, const bf16_t* __restrict__ KF, unsigned* __restrict__ nrm) {
    const int gw = F.vcu * NWAVES + F.wave, NGW = F.G * NWAVES, lane = lane_id_asm();
    for (int it = gw; it < 32 * 32; it += NGW) {
        const int bh = it >> 5, ck = it & 31, b = bh >> 3, h = bh & 7; float qm = 0.f, km = 0.f;
#pragma unroll
        for (int rr = 0; rr < 2; ++rr) { const size_t row = (size_t)b * S_ + ck * 128 + 2 * lane + rr; float qs = 0.f, ks = 0.f;
#pragma unroll
            for (int c = 0; c < 8; ++c) { const v4u q = *(const v4u*)(QF + row * 512 + h * 64 + c * 8), k = *(const v4u*)(KF + row * 512 + h * 64 + c * 8);
#pragma unroll
                for (int x = 0; x < 4; ++x) { const float q0 = __uint_as_float(q[x] << 16), q1 = __uint_as_float(q[x] & 0xffff0000u), k0 = __uint_as_float(k[x] << 16), k1 = __uint_as_float(k[x] & 0xffff0000u);
                    qs += q0 * q0 + q1 * q1; ks += k0 * k0 + k1 * k1; } }
            qm = fmaxf(qm, qs); km = fmaxf(km, ks); }
#pragma unroll
        for (int o = 1; o < 64; o <<= 1) { qm = fmaxf(qm, __shfl_xor(qm, o)); km = fmaxf(km, __shfl_xor(km, o)); }
        if (lane == 0) { atomicMax(nrm + bh, __float_as_uint(km)); atomicMax(nrm + 64 + bh * 16 + (ck >> 1), __float_as_uint(qm)); }
    }
}

__device__ __forceinline__ void cumsum_phase(const Frame& F, const float* __restrict__ LF, float* __restrict__ F2) {
    const int gw = F.vcu * NWAVES + F.wave, lane = lane_id_asm(); if (gw >= 32) return;
    const f32x4* src = (const f32x4*)(LF + (size_t)gw * S_ + lane * 64); f32x4 v[16]; float s = 0.f;
#pragma unroll
    for (int i = 0; i < 16; ++i) { v[i] = src[i]; }
#pragma unroll
    for (int i = 0; i < 16; ++i) { v[i][0] = s + v[i][0]; v[i][1] = v[i][0] + v[i][1]; v[i][2] = v[i][1] + v[i][2]; v[i][3] = v[i][2] + v[i][3]; s = v[i][3]; }
    float incl = s;
#pragma unroll
    for (int o = 1; o < 64; o <<= 1) { const float t = __shfl_up(incl, o); if (lane >= o) incl += t; }
    const float base = incl - s; f32x4* dst = (f32x4*)(F2 + (size_t)gw * S_ + lane * 64);
#pragma unroll
    for (int i = 0; i < 16; ++i) dst[i] = (v[i] + base) * LOG2E;
}

namespace ret_body {
typedef short bf16x8 __attribute__((ext_vector_type(8)));
typedef float f32x4 __attribute__((ext_vector_type(4)));
constexpr int QS = 72, VS = 136;
constexpr int LQ = 0, LK = LQ + 128 * QS * 2, LVT = LK + 128 * QS * 2, LPT = LVT + 128 * VS * 2, LCF = LPT + 128 * QS * 2, LDS_BYTES = LCF + 512;
__device__ __forceinline__ float lg2_of(int h) { return log2f(1.0f - exp2f(-5.0f - (float)h)); }
#define RET_MFMA(a, b, c) __builtin_amdgcn_mfma_f32_16x16x32_bf16(a, b, c, 0, 0, 0)
__device__ __forceinline__ void stage_vt(LAS unsigned char* lds, const bf16_t* __restrict__ RV, size_t t0, int h, int tid) {
    LAS bf16_t* VT = (LAS bf16_t*)(lds + LVT);
#pragma unroll
    for (int i = 0; i < 4; ++i) { const int c = tid + 512 * i, j = c & 127, ch = c >> 7; const v4u v = *(const v4u*)(RV + (t0 + j) * 1024 + h * 128 + ch * 8);
#pragma unroll
        for (int x = 0; x < 4; ++x) { VT[(ch * 8 + 2 * x) * VS + j] = (bf16_t)(v[x] & 0xffffu); VT[(ch * 8 + 2 * x + 1) * VS + j] = (bf16_t)(v[x] >> 16); } }
}
__device__ __forceinline__ void r1_unit(LAS unsigned char* lds, const bf16_t* __restrict__ RK, const bf16_t* __restrict__ RV, float* __restrict__ KVNT, int unit, int wid, int lane) {
    const int bh = unit >> 5, n = unit & 31, b = bh >> 3, h = bh & 7, tid = wid * 64 + lane; const size_t t0 = (size_t)b * S_ + n * 128; const float lg2 = lg2_of(h);
    stage_vt(lds, RV, t0, h, tid);
    LAS bf16_t* KZT = (LAS bf16_t*)(lds + LQ);
#pragma unroll
    for (int i = 0; i < 2; ++i) { const int c = tid + 512 * i, j = c & 127, ch = c >> 7; const v4u v = *(const v4u*)(RK + (t0 + j) * 512 + h * 64 + ch * 8); const float z = exp2f((float)(127 - j) * lg2);
#pragma unroll
        for (int x = 0; x < 4; ++x) { KZT[(ch * 8 + 2 * x) * VS + j] = f2bf(__uint_as_float(v[x] << 16) * z); KZT[(ch * 8 + 2 * x + 1) * VS + j] = f2bf(__uint_as_float(v[x] & 0xffff0000u) * z); } }
    __syncthreads();
    const int il = lane & 15, fq = lane >> 4;
    f32x4 acc[4];
#pragma unroll
    for (int db = 0; db < 4; ++db) acc[db] = (f32x4){0.f, 0.f, 0.f, 0.f};
#pragma unroll
    for (int ks = 0; ks < 4; ++ks) { const bf16x8 a = *(const LAS bf16x8*)(lds + LVT + ((16 * wid + il) * VS + 32 * ks + 8 * fq) * 2);
#pragma unroll
        for (int db = 0; db < 4; ++db) { const bf16x8 bq = *(const LAS bf16x8*)(lds + LQ + ((16 * db + il) * VS + 32 * ks + 8 * fq) * 2); acc[db] = RET_MFMA(a, bq, acc[db]); } }
    float* dst = KVNT + ((size_t)unit * 128 + 16 * wid + 4 * fq) * 64 + il;
#pragma unroll
    for (int db = 0; db < 4; ++db)
#pragma unroll
        for (int r = 0; r < 4; ++r) dst[r * 64 + db * 16] = acc[db][r];
    __syncthreads();
}
__device__ __forceinline__ void r2_unit(LAS unsigned char* lds, const bf16_t* __restrict__ RQ, const bf16_t* __restrict__ RK, const bf16_t* __restrict__ RV, const float* __restrict__ PREVT,
                                        const float* __restrict__ gn_g, const bf16_t* __restrict__ SG, bf16_t* __restrict__ AO, int unit, int wid, int lane) {
    const int bh = unit >> 5, n = unit & 31, b = bh >> 3, h = bh & 7, tid = wid * 64 + lane; const size_t t0 = (size_t)b * S_ + n * 128; const float lg2 = lg2_of(h);
    stage_vt(lds, RV, t0, h, tid);
#pragma unroll
    for (int i = 0; i < 2; ++i) { const int c = tid + 512 * i, row = c >> 3, ch = c & 7;
        *(LAS v4u*)(lds + LQ + (row * QS + ch * 8) * 2) = *(const v4u*)(RQ + (t0 + row) * 512 + h * 64 + ch * 8);
        *(LAS v4u*)(lds + LK + (row * QS + ch * 8) * 2) = *(const v4u*)(RK + (t0 + row) * 512 + h * 64 + ch * 8); }
    { const float* pv = PREVT + (size_t)unit * 8192;
#pragma unroll
      for (int i = 0; i < 4; ++i) { const int c = tid + 512 * i, e = c >> 4, d4 = (c & 15) * 4; const f32x4 v = *(const f32x4*)(pv + e * 64 + d4); v2u w; w.x = cvt_pk_bf16(v[0], v[1]); w.y = cvt_pk_bf16(v[2], v[3]);
          *(LAS v2u*)(lds + LPT + (e * QS + d4) * 2) = w; } }
    if (tid < 128) ((LAS float*)(lds + LCF))[tid] = exp2f(-(float)tid * lg2);
    __syncthreads();
    const int il = lane & 15, fq = lane >> 4, i0 = 16 * wid, il_i = i0 + il;
    bf16x8 qf[2];
#pragma unroll
    for (int ks = 0; ks < 2; ++ks) qf[ks] = *(const LAS bf16x8*)(lds + LQ + ((i0 + il) * QS + 32 * ks + 8 * fq) * 2);
    const float rowf = exp2f((float)il_i * lg2);
    f32x4 st[8];
#pragma unroll
    for (int jb = 0; jb < 8; ++jb) {
        st[jb] = (f32x4){0.f, 0.f, 0.f, 0.f};
        if (jb <= wid) {
#pragma unroll
            for (int ks = 0; ks < 2; ++ks) { const bf16x8 kf = *(const LAS bf16x8*)(lds + LK + ((16 * jb + il) * QS + 32 * ks + 8 * fq) * 2); st[jb] = RET_MFMA(kf, qf[ks], st[jb]); }
            const f32x4 cf = *(const LAS f32x4*)(lds + LCF + (16 * jb + 4 * fq) * 4);
#pragma unroll
            for (int r = 0; r < 4; ++r) { const int j = 16 * jb + 4 * fq + r; st[jb][r] = (j <= il_i) ? st[jb][r] * rowf * cf[r] : 0.f; }
        }
    }
    f32x4 oacc[8], cacc[8];
#pragma unroll
    for (int eb = 0; eb < 8; ++eb) { oacc[eb] = (f32x4){0.f, 0.f, 0.f, 0.f}; cacc[eb] = (f32x4){0.f, 0.f, 0.f, 0.f}; }
#pragma unroll
    for (int s = 0; s < 4; ++s) {
        if (2 * s <= wid) {
            v4u pw; pw.x = cvt_pk_bf16(st[2 * s][0], st[2 * s][1]); pw.y = cvt_pk_bf16(st[2 * s][2], st[2 * s][3]); pw.z = cvt_pk_bf16(st[2 * s + 1][0], st[2 * s + 1][1]); pw.w = cvt_pk_bf16(st[2 * s + 1][2], st[2 * s + 1][3]);
            const bf16x8 pb = __builtin_bit_cast(bf16x8, pw);
#pragma unroll
            for (int eb = 0; eb < 8; ++eb) { const LAS unsigned char* vp = lds + LVT + ((16 * eb + il) * VS + 32 * s + 4 * fq) * 2;
                const v2u lo = *(const LAS v2u*)vp, hi = *(const LAS v2u*)(vp + 32); v4u aw; aw.x = lo.x; aw.y = lo.y; aw.z = hi.x; aw.w = hi.y;
                oacc[eb] = RET_MFMA(__builtin_bit_cast(bf16x8, aw), pb, oacc[eb]); }
        }
    }
#pragma unroll
    for (int ks = 0; ks < 2; ++ks)
#pragma unroll
        for (int eb = 0; eb < 8; ++eb) { const bf16x8 pf = *(const LAS bf16x8*)(lds + LPT + ((16 * eb + il) * QS + 32 * ks + 8 * fq) * 2); cacc[eb] = RET_MFMA(pf, qf[ks], cacc[eb]); }
    const float xi = exp2f((float)(il_i + 1) * lg2);
    float s1 = 0.f;
#pragma unroll
    for (int eb = 0; eb < 8; ++eb) { oacc[eb] = oacc[eb] + cacc[eb] * xi; s1 += (oacc[eb][0] + oacc[eb][1]) + (oacc[eb][2] + oacc[eb][3]); }
    s1 += __shfl_xor(s1, 16); s1 += __shfl_xor(s1, 32);
    const float mu = s1 * (1.f / 128.f); float s2 = 0.f;
#pragma unroll
    for (int eb = 0; eb < 8; ++eb) { const f32x4 d = oacc[eb] - mu; s2 += (d[0] * d[0] + d[1] * d[1]) + (d[2] * d[2] + d[3] * d[3]); }
    s2 += __shfl_xor(s2, 16); s2 += __shfl_xor(s2, 32);
    const float rs = rsqrtf(s2 * (1.f / 128.f) + EPS);
    const size_t t = t0 + il_i;
#pragma unroll
    for (int eb = 0; eb < 8; ++eb) { const int e = h * 128 + 16 * eb + 4 * fq; const f32x4 g = *(const f32x4*)(gn_g + e); const v2u sg = *(const v2u*)(SG + t * 1024 + e);
        f32x4 y = (oacc[eb] - mu) * rs * g; y[0] *= __uint_as_float(sg.x << 16); y[1] *= __uint_as_float(sg.x & 0xffff0000u); y[2] *= __uint_as_float(sg.y << 16); y[3] *= __uint_as_float(sg.y & 0xffff0000u);
        v2u w; w.x = cvt_pk_bf16(y[0], y[1]); w.y = cvt_pk_bf16(y[2], y[3]); *(v2u*)(AO + t * 1536 + 512 + e) = w; }
    __syncthreads();
}
#undef RET_MFMA
}

constexpr int TAB_OFF = LDSCTL_OFF + 1024;
struct MoeOrder {
    const LAS int* tabStart; const LAS int* tabCnt; const LAS int* tabE; const int* LTOK; int nunits, pnshift, G, c;
    const float* W0; const float* W1; int up;
    __device__ __forceinline__ bool next(int i, pg8::Unit& u) const {
        const int L = i * G + c; if (L >= nunits) return false;
        const int blk = L >> pnshift, e = tabE[blk]; u.pm = blk; u.pn = (e << pnshift) + (L & ((1 << pnshift) - 1)); return true;
    }
    __device__ __forceinline__ int rows(const pg8::Unit& u) const { const int e = u.pn >> pnshift; return tabCnt[e] - (u.pm - tabStart[e]) * 256; }
    __device__ __forceinline__ int row_id(const pg8::Unit& u, int r) const {
        if (!up) return u.pm * 256 + r;
        const int e = u.pn >> pnshift, idx = (u.pm - tabStart[e]) * 256 + r, last = tabCnt[e] - 1; return LTOK[(size_t)e * CAP + (idx < last ? idx : last)];
    }
    __device__ __forceinline__ unsigned off_of(int id) const { return up ? (unsigned)(id >> 3) * (unsigned)(D_ * 2) : (unsigned)id * 512u; }
    __device__ __forceinline__ const float* b_ptr(const pg8::Unit& u, int cg, int i) const {
        const int e = u.pn >> pnshift, pnl = u.pn & ((1 << pnshift) - 1);
        return up ? ((cg & 1) ? W1 : W0) + (size_t)e * 1024 * 256 + pnl * 64 + (cg >> 1) * 32 + 4 * i : W0 + (size_t)e * 256 * 1024 + pnl * 128 + cg * 32 + 4 * i;
    }
    __device__ __forceinline__ int b_row(int cg, int i) const { return up ? 32 * (2 * (cg >> 1) + (i >> 2)) + 16 * (cg & 1) + 4 * (i & 3) : 32 * cg + 16 * (i & 1) + 4 * (i >> 1); }
    __device__ __forceinline__ void a_ready(const pg8::Unit&) const {}
    __device__ __forceinline__ void done(const pg8::Unit&) const {}
};
__device__ __forceinline__ int moe_tables(const Frame& F, const unsigned* __restrict__ CNT) {
    LAS int* tabStart = (LAS int*)(F.lds + TAB_OFF); LAS int* tabCnt = tabStart + 260; LAS int* tabE = tabCnt + 256;
    const int lane = lane_id_asm();
    __syncthreads();
    if (F.wave == 0) {
        int c[4], nb[4], s = 0;
#pragma unroll
        for (int i = 0; i < 4; ++i) { c[i] = (int)__hip_atomic_load(CNT + (lane * 4 + i) * CNT_STRIDE, __ATOMIC_RELAXED, __HIP_MEMORY_SCOPE_AGENT); nb[i] = (c[i] + 255) >> 8; s += nb[i]; }
        int incl = s;
#pragma unroll
        for (int o = 1; o < 64; o <<= 1) { const int t = __shfl_up(incl, o); if (lane >= o) incl += t; }
        int run = incl - s;
#pragma unroll
        for (int i = 0; i < 4; ++i) { tabStart[lane * 4 + i] = run; tabCnt[lane * 4 + i] = c[i]; run += nb[i]; }
        if (lane == 63) tabStart[256] = run;
    }
    __syncthreads();
    const int tid = F.wave * 64 + lane;
    if (tid < 256) { const int b0 = tabStart[tid], b1 = tabStart[tid + 1]; for (int b = b0; b < b1; ++b) tabE[b] = tid; }
    __syncthreads();
    return tabStart[256];
}
__device__ __forceinline__ void route_phase(const Frame& F, const float* __restrict__ SC, const float* __restrict__ rbias, unsigned* __restrict__ CNT, int* __restrict__ LTOK, float* __restrict__ LW) {
    const int gw = F.vcu * NWAVES + F.wave, NGW = F.G * NWAVES, lane = lane_id_asm(), g = lane & 7, lbase = lane & ~7;
    for (int tb = gw * 8; tb < T_; tb += NGW * 8) {
        const int t = tb + (lane >> 3);
        float sel[32];
        { const f32x4* sp = (const f32x4*)(SC + (size_t)t * 256 + 32 * g); const f32x4* bp = (const f32x4*)(rbias + 32 * g);
#pragma unroll
          for (int i = 0; i < 8; ++i) { const f32x4 a = sp[i], bb = bp[i]; sel[4 * i] = a[0] + bb[0]; sel[4 * i + 1] = a[1] + bb[1]; sel[4 * i + 2] = a[2] + bb[2]; sel[4 * i + 3] = a[3] + bb[3]; } }
        float m1 = fmaxf(sel[0], sel[1]), m2 = fminf(sel[0], sel[1]);
#pragma unroll
        for (int i = 2; i < 32; ++i) { const float v = sel[i]; m2 = fmaxf(m2, fminf(m1, v)); m1 = fmaxf(m1, v); }
        const float gs = m1 + m2; int rank = 0;
#pragma unroll
        for (int gg = 0; gg < 8; ++gg) { const float o = __shfl(gs, lbase + gg); rank += (o > gs || (o == gs && gg < g)) ? 1 : 0; }
        const bool allowed = rank < 4;
        float lv[8]; int li[8]; unsigned taken = 0u;
#pragma unroll
        for (int r = 0; r < 8; ++r) { float bv = -INFINITY; int bi = 0;
#pragma unroll
            for (int i = 0; i < 32; ++i) { const bool better = !((taken >> i) & 1u) && sel[i] > bv; bv = better ? sel[i] : bv; bi = better ? i : bi; }
            taken |= 1u << bi; lv[r] = allowed ? bv : -INFINITY; li[r] = 32 * g + bi; }
        int myE = 0;
#pragma unroll
        for (int r = 0; r < 8; ++r) {
            float bv = lv[0]; int bi = li[0];
#pragma unroll
            for (int o = 1; o < 8; o <<= 1) { const float ov = __shfl_xor(bv, o); const int oi = __shfl_xor(bi, o); if (ov > bv || (ov == bv && oi < bi)) { bv = ov; bi = oi; } }
            if (bi == li[0] && lv[0] == bv) {
#pragma unroll
                for (int q = 0; q < 7; ++q) { lv[q] = lv[q + 1]; li[q] = li[q + 1]; }
                lv[7] = -INFINITY; }
            if (g == r) myE = bi;
        }
        const float mySc = SC[(size_t)t * 256 + myE];
        float tot = mySc;
#pragma unroll
        for (int o = 1; o < 8; o <<= 1) tot += __shfl_xor(tot, o);
        const float w = mySc / tot * 2.5f; const unsigned slot = atomicAdd(&CNT[myE * CNT_STRIDE], 1u); LTOK[(size_t)myE * CAP + slot] = t * 8 + g; LW[(size_t)myE * CAP + slot] = w;
    }
}
__device__ __forceinline__ void final_rows(const Frame& F, const float* __restrict__ X1, const bf16_t* __restrict__ YS, const bf16_t* __restrict__ SHO, const float* __restrict__ mod, const float* __restrict__ fg, float* __restrict__ out) {
    const int gw = F.vcu * NWAVES + F.wave, NGW = F.G * NWAVES, lane = lane_id_asm();
    for (int row = gw; row < T_; row += NGW) {
        const float* mg = mod + (row / S_) * 6144 + 5120; float v[16]; float s = 0.f;
#pragma unroll
        for (int j = 0; j < 2; ++j) { const int c0 = 8 * lane + 512 * j; float r[8];
            { const v4u w = *(const v4u*)(SHO + (size_t)row * D_ + c0);
#pragma unroll
              for (int x = 0; x < 4; ++x) { r[2 * x] = __uint_as_float(w[x] << 16); r[2 * x + 1] = __uint_as_float(w[x] & 0xffff0000u); } }
#pragma unroll
            for (int k = 0; k < 8; ++k) { const v4u w = *(const v4u*)(YS + ((size_t)row * 8 + k) * D_ + c0);
#pragma unroll
                for (int x = 0; x < 4; ++x) { r[2 * x] += __uint_as_float(w[x] << 16); r[2 * x + 1] += __uint_as_float(w[x] & 0xffff0000u); } }
#pragma unroll
            for (int h = 0; h < 2; ++h) { const f32x4 xv = *(const f32x4*)(X1 + (size_t)row * D_ + c0 + 4 * h), gv = *(const f32x4*)(mg + c0 + 4 * h);
#pragma unroll
                for (int x = 0; x < 4; ++x) { const float y = xv[x] + gv[x] * r[4 * h + x]; v[8 * j + 4 * h + x] = y; s += y * y; } } }
        const float rr = rsqrtf(wave_sum(s) * (1.f / D_) + EPS);
#pragma unroll
        for (int j = 0; j < 2; ++j)
#pragma unroll
            for (int h = 0; h < 2; ++h) { const int c0 = 8 * lane + 512 * j + 4 * h; const f32x4 g = *(const f32x4*)(fg + c0); f32x4 o;
#pragma unroll
                for (int x = 0; x < 4; ++x) o[x] = v[8 * j + 4 * h + x] * rr * g[x];
                *(f32x4*)(out + (size_t)row * D_ + c0) = o; }
    }
}

__global__ void __launch_bounds__(NWAVES * 64, 2) mk_fwd(Args args) {
    extern __shared__ __attribute__((aligned(16))) unsigned char lds[];
    Frame F;
    F.lds = (LAS unsigned char*)lds; F.MISC = (volatile LAS unsigned*)(F.lds + MISC_OFF);
    F.wave = __builtin_amdgcn_readfirstlane(threadIdx.x >> 6);
    F.G = gridDim.x; { const int bx = blockIdx.x; F.vcu = (F.G % 8 == 0) ? (bx % 8) * (F.G / 8) + bx / 8 : bx; }
    unsigned char* ws = args.ws; F.ctl = (unsigned*)(ws + WS_CTL);
    for (int u = threadIdx.x; u < (LDS_BYTES - LDSCTL_OFF) / 4; u += NWAVES * 64) ((LAS unsigned*)(F.lds + LDSCTL_OFF))[u] = 0u;
    __syncthreads();
    unsigned* barw = F.ctl + CW_BAR + args.bar_region * XCD_BAR_WORDS;
    XcdBarrier bar; bar.bar = barw; bar.x = 0; bar.st = nullptr;
    if (args.use_bar) bar = xcd_barrier_post(barw, F.MISC + 8);
    const int lo = args.ph_lo, hi = args.ph_hi;
#ifndef PH_OFF
#define PH_OFF 0
#endif
#define IN(k) (!((PH_OFF >> (k)) & 1) && lo <= (k) && (k) < hi)
#define SEAM(k) do { if (IN(k) && IN((k) + 1)) xcd_barrier(bar, F.wave); } while (0)
    float* MOD = (float*)(ws + WS_MOD); bf16_t* XN = (bf16_t*)(ws + WS_XN);

    if (IN(0)) { p0_prologue(args, F); } SEAM(0);
    if (IN(1)) { norm_mod_rows(F, args.in[0], args.in[4], MOD, 0, 1024, XN); } SEAM(1);
    if (IN(2)) {
        pg8::Gemm g{XN, (const bf16_t*)(ws + WS_WIN), T_, NIN, D_, D_, D_}; pg8::StaticOrder S; S.init(T_, NIN, F.G, (int)blockIdx.x);
        pg8::EpiInproj E{(bf16_t*)(ws + WS_QF), (bf16_t*)(ws + WS_KF), (bf16_t*)(ws + WS_VF), (bf16_t*)(ws + WS_RQ), (bf16_t*)(ws + WS_RK), (bf16_t*)(ws + WS_RV), (bf16_t*)(ws + WS_SG),
                         (bf16_t*)(ws + WS_GA), (bf16_t*)(ws + WS_GB), (float*)(ws + WS_LF), (const float*)(ws + WS_COS), (const float*)(ws + WS_SIN), args.in[6]};
        pg8::gemm_phase<pg8::EpiInproj, pg8::StaticOrder, true, true>(F.lds + RING_OFF, g, S, E, F.wave);
    } SEAM(2);
    if (IN(3)) {
        cumsum_phase(F, (const float*)(ws + WS_LF), (float*)(ws + WS_F2));
        qk_norm_phase(F, (const bf16_t*)(ws + WS_QF), (const bf16_t*)(ws + WS_KF), F.ctl + CW_NRM);
        const int lane = lane_id_asm();
        for (int u = blockIdx.x; u < 1024; u += F.G) ret_body::r1_unit(F.lds + RING_OFF, (const bf16_t*)(ws + WS_RK), (const bf16_t*)(ws + WS_RV), (float*)(ws + WS_KVN), u, F.wave, lane);
    } SEAM(3);
    if (IN(4)) {
        float* KV = (float*)(ws + WS_KVN); const int tid = F.wave * 64 + lane_id_asm();
        for (int idx = blockIdx.x * 512 + tid; idx < 32 * 8192; idx += F.G * 512) { const int bh = idx >> 13, r = idx & 8191; const float cd = exp2f(128.f * ret_body::lg2_of(bh & 7));
            float* p = KV + (size_t)bh * 32 * 8192 + r; float kv[32];
#pragma unroll
            for (int n = 0; n < 32; ++n) kv[n] = p[(size_t)n * 8192];
            float st = 0.f;
#pragma unroll
            for (int n = 0; n < 32; ++n) { p[(size_t)n * 8192] = st; st = cd * st + kv[n]; } }
    } SEAM(4);
    if (IN(5)) {
        static_assert(attn_body::ATTN_LDS_BYTES <= RING_BYTES && ret_body::LDS_BYTES <= RING_BYTES, "attention / retention LDS");
        const attn_body::AttnTensors AT{(const attn_body::bf16*)(ws + WS_QF), (const attn_body::bf16*)(ws + WS_KF), (const attn_body::bf16*)(ws + WS_VF), (attn_body::bf16*)(ws + WS_AO), (const float*)(ws + WS_F2), F.ctl + CW_NRM};
        attn_body::attn_phase_queue<8>((char*)lds + RING_OFF, AT, F.ctl + CW_QUEUE, F.MISC + 12, F.wave);
        const int lane = lane_id_asm();
        for (int u = blockIdx.x; u < 1024; u += F.G) ret_body::r2_unit(F.lds + RING_OFF, (const bf16_t*)(ws + WS_RQ), (const bf16_t*)(ws + WS_RK), (const bf16_t*)(ws + WS_RV), (const float*)(ws + WS_KVN),
                                                                       args.in[7], (const bf16_t*)(ws + WS_SG), (bf16_t*)(ws + WS_AO), u, F.wave, lane);
    } SEAM(5);
    if (IN(6)) {
        pg8::Gemm g{(const bf16_t*)(ws + WS_AO), (const bf16_t*)(ws + WS_WAB), T_, D_, 1536, 1536, 1536}; pg8::StaticOrder S; S.init(T_, D_, F.G, (int)blockIdx.x);
        pg8::EpiMerge E{(bf16_t*)(ws + WS_MRG), (const bf16_t*)(ws + WS_GA), (const bf16_t*)(ws + WS_GB), 8};
        pg8::gemm_phase<pg8::EpiMerge, pg8::StaticOrder, true, true>(F.lds + RING_OFF, g, S, E, F.wave);
    } SEAM(6);
    if (IN(7)) {
        pg8::Gemm g{(const bf16_t*)(ws + WS_MRG), (const bf16_t*)(ws + WS_WO), T_, D_, D_, D_, D_}; pg8::StaticOrder S; S.init(T_, D_, F.G, (int)blockIdx.x);
        pg8::EpiX1 E{args.in[0], MOD, (float*)(ws + WS_X1)};
        pg8::gemm_phase<pg8::EpiX1, pg8::StaticOrder, true, true>(F.lds + RING_OFF, g, S, E, F.wave);
    } SEAM(7);
    if (IN(8)) { norm_mod_rows(F, (const float*)(ws + WS_X1), args.in[11], MOD, 3072, 4096, XN); } SEAM(8);
    if (IN(9)) {
        pg8::Gemm g{XN, (const bf16_t*)(ws + WS_WRS), T_, 768, D_, D_, D_}; pg8::StaticOrder S; S.init(T_, 768, F.G, (int)blockIdx.x);
        pg8::EpiRS E{(float*)(ws + WS_SCORES), (bf16_t*)(ws + WS_HS)};
        pg8::gemm_phase<pg8::EpiRS, pg8::StaticOrder, true, true>(F.lds + RING_OFF, g, S, E, F.wave);
    } SEAM(9);
    if (IN(10)) {
        pg8::Gemm g{(const bf16_t*)(ws + WS_HS), (const bf16_t*)(ws + WS_WSD), T_, D_, 256, 256, 256}; pg8::StaticOrder S; S.init(T_, D_, F.G, (int)blockIdx.x);
        pg8::EpiPlain<1024> E{(bf16_t*)(ws + WS_MRG)};
        pg8::gemm_phase<pg8::EpiPlain<1024>, pg8::StaticOrder, true, true>(F.lds + RING_OFF, g, S, E, F.wave);
    } SEAM(10);
    if (IN(11)) { route_phase(F, (const float*)(ws + WS_SCORES), args.in[13], F.ctl + CW_CNT, (int*)(ws + WS_LTOK), (float*)(ws + WS_LW)); } SEAM(11);
    if (IN(12)) {
        const int nblk = moe_tables(F, F.ctl + CW_CNT);
        const LAS int* tabStart = (const LAS int*)(F.lds + TAB_OFF);
        MoeOrder S{tabStart, tabStart + 260, tabStart + 516, (const int*)(ws + WS_LTOK), nblk * 4, 2, F.G, F.vcu, args.in[14], args.in[15], 1};
        pg8::Gemm g{XN, nullptr, 0, 0, D_, D_, 256};
        pg8::EpiMoeUp E{(bf16_t*)(ws + WS_HE)};
        pg8::gemm_moe<pg8::EpiMoeUp, MoeOrder>(F.lds + RING_OFF, g, S, E, F.wave);
    } SEAM(12);
    if (IN(13)) {
        const int nblk = moe_tables(F, F.ctl + CW_CNT);
        const LAS int* tabStart = (const LAS int*)(F.lds + TAB_OFF);
        MoeOrder S{tabStart, tabStart + 260, tabStart + 516, (const int*)(ws + WS_LTOK), nblk * 8, 3, F.G, F.vcu, args.in[16], nullptr, 0};
        pg8::Gemm g{(const bf16_t*)(ws + WS_HE), nullptr, 0, 0, 256, 256, 1024};
        pg8::EpiMoeDown E{(bf16_t*)(ws + WS_YS), (const int*)(ws + WS_LTOK), (const float*)(ws + WS_LW), tabStart, tabStart + 260};
        pg8::gemm_moe<pg8::EpiMoeDown, MoeOrder>(F.lds + RING_OFF, g, S, E, F.wave);
    } SEAM(13);
    if (IN(14)) { final_rows(F, (const float*)(ws + WS_X1), (const bf16_t*)(ws + WS_YS), (const bf16_t*)(ws + WS_MRG), MOD, args.in[20], args.out); }
#undef IN
#undef SEAM
}

extern "C" void kernel_launch(void* const* d_in, const int* in_sizes, int n_in, void* d_out, int out_size, void* d_ws, size_t ws_size, hipStream_t stream) {
    static int grid = 0;
    if (grid == 0) {
        if (n_in != 21 || ws_size < WS_END || out_size != T_ * D_) { fprintf(stderr, "kernel_launch: unexpected n_in %d / ws %zu / out %d\n", n_in, ws_size, out_size); grid = -1; return; }
        int dev = 0, cus = 0, per_cu = 0;
        (void)hipGetDevice(&dev); (void)hipDeviceGetAttribute(&cus, hipDeviceAttributeMultiprocessorCount, dev);
        if (hipFuncSetAttribute((const void*)mk_fwd, hipFuncAttributeMaxDynamicSharedMemorySize, LDS_BYTES) != hipSuccess) { fprintf(stderr, "kernel_launch: hipFuncSetAttribute failed\n"); grid = -1; return; }
        if (hipOccupancyMaxActiveBlocksPerMultiprocessor(&per_cu, (const void*)mk_fwd, NWAVES * 64, LDS_BYTES) != hipSuccess || per_cu < 1) { fprintf(stderr, "kernel_launch: occupancy query says %d\n", per_cu); per_cu = 1; }
        (void)hipGetLastError();
        grid = cus;
        if (grid != 256) fprintf(stderr, "kernel_launch: note: %d CUs\n", grid);
    }
    if (grid < 0) return;
    const float* x = (const float*)d_in[0]; const float* ret_gn_g = (const float*)d_in[7]; const float* norm2_g = (const float*)d_in[11];
    const float* router_bias = (const float*)d_in[13]; const float* final_g = (const float*)d_in[20];
    char* ws = (char*)d_ws; float* out = (float*)d_out;
    unsigned* CNT = (unsigned*)(ws + WS_CTL); float* MOD = (float*)(ws + WS_MOD);
    float* F2 = (float*)(ws + WS_F2); float* LF = (float*)(ws + WS_LF); int* BLK = (int*)(ws + WS_BLK);
    bf16_t* WIN = (bf16_t*)(ws + WS_WIN); bf16_t* WAB = (bf16_t*)(ws + WS_WAB); bf16_t* WO = (bf16_t*)(ws + WS_WO); bf16_t* WRS = (bf16_t*)(ws + WS_WRS); bf16_t* WSD = (bf16_t*)(ws + WS_WSD);
    bf16_t* WEG = (bf16_t*)(ws + WS_WEG); bf16_t* WED = (bf16_t*)(ws + WS_WED); bf16_t* XN = (bf16_t*)(ws + WS_XN);
    bf16_t* QF = (bf16_t*)(ws + WS_QF); bf16_t* KF = (bf16_t*)(ws + WS_KF); bf16_t* VF = (bf16_t*)(ws + WS_VF); bf16_t* RQ = (bf16_t*)(ws + WS_RQ); bf16_t* RK = (bf16_t*)(ws + WS_RK);
    bf16_t* RV = (bf16_t*)(ws + WS_RV); bf16_t* SG = (bf16_t*)(ws + WS_SG); bf16_t* GA = (bf16_t*)(ws + WS_GA); bf16_t* GB = (bf16_t*)(ws + WS_GB);
    bf16_t* AO = (bf16_t*)(ws + WS_AO); bf16_t* MRG = (bf16_t*)(ws + WS_MRG); float* X1 = (float*)(ws + WS_X1); float* KVN = (float*)(ws + WS_KVN);
    float* SCORES = (float*)(ws + WS_SCORES); bf16_t* HS = (bf16_t*)(ws + WS_HS); int* LTOK = (int*)(ws + WS_LTOK); float* LW = (float*)(ws + WS_LW);
    bf16_t* HE = (bf16_t*)(ws + WS_HE); bf16_t* YS = (bf16_t*)(ws + WS_YS);

    (void)hipMemsetAsync(ws + WS_CTL, 0, 1 * MiB, stream);
    (void)hipMemsetAsync(WIN + (size_t)6664 * D_, 0, (size_t)(NIN - 6664) * D_ * 2, stream);
    Args a{};
    for (int i = 0; i < 21; ++i) a.in[i] = (const float*)d_in[i];
    a.out = out; a.ws = (unsigned char*)d_ws; a.ph_lo = 0; a.ph_hi = 15; a.use_bar = 1; a.bar_region = 0;
    void* kargs[] = {&a};
    hipError_t le = hipLaunchCooperativeKernel((const void*)mk_fwd, dim3(grid), dim3(NWAVES * 64), kargs, LDS_BYTES, stream);
    if (le != hipSuccess) fprintf(stderr, "kernel_launch: cooperative launch failed: %s\n", hipGetErrorString(le));
}
```
